# Optimizing an MI355X kernel written in HIP

```python
import math
import jax, jax.numpy as jnp
from jax import lax
import numpy as np

D_MODEL = 1024
BATCH = 16
SEQ = 4096
DEPTH = 2

EPS = 1e-6
SSD_HEADS = 16
SSD_HEAD_DIM = 64
SSD_WIDTH = SSD_HEADS * SSD_HEAD_DIM
SSD_GROUPS = 2
SSD_STATE = 128
SSD_CONV = 4
SSD_CHUNK = 128
SSD_CONV_CH = SSD_WIDTH + 2 * SSD_GROUPS * SSD_STATE
DT_MIN = 1e-3
DT_MAX = 1e-1
POOL_GROUPS = 4
POOL_GROUP_DIM = 128
POOL_WIDTH = POOL_GROUPS * POOL_GROUP_DIM
POOL_WINDOWS = (2, 4, 8, 16)
MLA_HEADS = 8
MLA_Q_RANK = 384
MLA_KV_RANK = 256
MLA_NOPE = 64
MLA_ROPE = 32
MLA_V = 64
MLA_QK = MLA_NOPE + MLA_ROPE
MLA_WIDTH = MLA_HEADS * MLA_V
ROPE_THETA = 10000.0
Q_BLOCK = 128
MIX_WIDTH = SSD_WIDTH + POOL_WIDTH + MLA_WIDTH
IN_SIZES = (SSD_WIDTH, SSD_CONV_CH, SSD_HEADS, POOL_WIDTH, MLA_Q_RANK, MLA_KV_RANK, MLA_ROPE)
IN_COLS = SSD_WIDTH + SSD_CONV_CH + SSD_HEADS + POOL_WIDTH + MLA_Q_RANK + MLA_KV_RANK + MLA_ROPE
D_FF = 2816
FFN_CONV = 3

kernel_name = "hybrid_ssd_pool_mla_convffn"


def rmsnorm(x, w):
    xf = x.astype(jnp.float32)
    var = jnp.mean(xf * xf, axis=-1, keepdims=True)
    return (xf * lax.rsqrt(var + EPS)).astype(x.dtype) * w


def causal_dwconv(x, w, b):
    K = w.shape[0]
    S = x.shape[1]
    xp = jnp.pad(x, ((0, 0), (K - 1, 0), (0, 0)))
    acc = xp[:, 0:S] * w[0] + b
    for k in range(1, K):
        acc = acc + xp[:, k:k + S] * w[k]
    return acc


def rope(x, cos, sin):
    x1, x2 = jnp.split(x, 2, axis=-1)
    return jnp.concatenate([x1 * cos - x2 * sin, x1 * sin + x2 * cos], axis=-1)


def rope_tables(positions):
    inv_freq = ROPE_THETA ** (-jnp.arange(0, MLA_ROPE, 2, dtype=jnp.float32) / MLA_ROPE)
    ang = positions.astype(jnp.float32)[..., None] * inv_freq
    return jnp.cos(ang), jnp.sin(ang)


def ssd_mixer(z, xbc, dt_raw, conv_w, conv_b, dt_bias, a_log, d_skip, norm_w):
    Bsz, S, _ = xbc.shape
    G, E, P, N, L = SSD_GROUPS, SSD_HEADS // SSD_GROUPS, SSD_HEAD_DIM, SSD_STATE, SSD_CHUNK
    nc = S // L
    xbc = jax.nn.silu(causal_dwconv(xbc, conv_w, conv_b))
    xs, bs, cs = jnp.split(xbc, [SSD_WIDTH, SSD_WIDTH + G * N], axis=-1)
    xs = xs.reshape(Bsz, nc, L, G, E, P)
    bs = bs.reshape(Bsz, nc, L, G, N)
    cs = cs.reshape(Bsz, nc, L, G, N)
    dt = jax.nn.softplus((dt_raw + dt_bias).astype(jnp.float32)).reshape(Bsz, nc, L, G, E)
    a = -jnp.exp(a_log.astype(jnp.float32)).reshape(G, E)
    da = dt * a
    xdt = xs * dt[..., None]
    da_cum = jnp.cumsum(da, axis=2)
    causal = jnp.tril(jnp.ones((L, L), dtype=bool))
    seg = da_cum[:, :, :, None] - da_cum[:, :, None, :]
    decay = jnp.exp(jnp.where(causal[None, None, :, :, None, None], seg, -jnp.inf))
    cb = jnp.einsum("bclgn,bcsgn->bclsg", cs, bs)
    y_diag = jnp.einsum("bclsg,bclsge,bcsgep->bclgep", cb, decay, xdt)
    decay_to_end = jnp.exp(da_cum[:, :, -1:] - da_cum)
    chunk_states = jnp.einsum("bclgn,bclge,bclgep->bcgepn", bs, decay_to_end, xdt)
    chunk_decay = jnp.exp(da_cum[:, :, -1])

    def step(h, inp):
        dec, st = inp
        return h * dec[..., None, None] + st, h

    h0 = jnp.zeros((Bsz, G, E, P, N), dtype=chunk_states.dtype)
    _, h_in = lax.scan(step, h0, (jnp.moveaxis(chunk_decay, 1, 0), jnp.moveaxis(chunk_states, 1, 0)))
    h_in = jnp.moveaxis(h_in, 0, 1)
    y_off = jnp.einsum("bclgn,bcgepn,bclge->bclgep", cs, h_in, jnp.exp(da_cum))
    y = y_diag + y_off + xs * d_skip.reshape(G, E)[:, :, None]
    y = y.reshape(Bsz, S, SSD_WIDTH)
    return rmsnorm(y * jax.nn.silu(z), norm_w)


def pool_mixer(u, pool_w, pool_scale):
    Bsz, S, _ = u.shape
    uf = u.astype(jnp.float32)
    csum = jnp.pad(jnp.cumsum(uf, axis=1), ((0, 0), (1, 0), (0, 0)))
    count = jnp.arange(1, S + 1, dtype=jnp.float32)[:, None]
    means = []
    for gi, w in enumerate(POOL_WINDOWS):
        c = csum[:, :, gi * POOL_GROUP_DIM:(gi + 1) * POOL_GROUP_DIM]
        lag = jnp.pad(c, ((0, 0), (w - 1, 0), (0, 0)))[:, :S]
        means.append((c[:, 1:] - lag) / jnp.minimum(count, float(w)))
    pooled = (jnp.concatenate(means, axis=-1) - uf).astype(u.dtype)
    pooled = pooled.reshape(Bsz, S, POOL_GROUPS, POOL_GROUP_DIM)
    y = jnp.einsum("bsgc,gcd->bsgd", pooled, pool_w).reshape(Bsz, S, POOL_WIDTH)
    return y * pool_scale


def mla_mixer(c_q, c_kv, k_pe, cos, sin, q_norm, w_uq, kv_norm, w_ukv):
    Bsz, S, _ = c_q.shape
    H = MLA_HEADS
    q = (rmsnorm(c_q, q_norm) @ w_uq).reshape(Bsz, S, H, MLA_QK)
    kv = (rmsnorm(c_kv, kv_norm) @ w_ukv).reshape(Bsz, S, H, MLA_NOPE + MLA_V)
    q_nope, q_pe = jnp.split(q, [MLA_NOPE], axis=-1)
    k_nope, v = jnp.split(kv, [MLA_NOPE], axis=-1)
    q_pe = rope(q_pe, cos[:, :, None, :], sin[:, :, None, :])
    k_pe = rope(k_pe, cos, sin)
    q = jnp.concatenate([q_nope, q_pe], axis=-1)
    k = jnp.concatenate([k_nope, jnp.broadcast_to(k_pe[:, :, None, :], (Bsz, S, H, MLA_ROPE))], axis=-1)
    scale = 1.0 / math.sqrt(MLA_QK)
    nb = S // Q_BLOCK
    qb = jnp.moveaxis(q.reshape(Bsz, nb, Q_BLOCK, H, MLA_QK), 1, 0)
    key_pos = jnp.arange(S)

    def attend(args):
        q_blk, i = args
        s = jnp.einsum("bqhd,bkhd->bhqk", q_blk, k).astype(jnp.float32) * scale
        q_pos = i * Q_BLOCK + jnp.arange(Q_BLOCK)
        s = jnp.where(key_pos[None, :] <= q_pos[:, None], s, -jnp.inf)
        p = jax.nn.softmax(s, axis=-1).astype(v.dtype)
        return jnp.einsum("bhqk,bkhd->bqhd", p, v)

    o = lax.map(attend, (qb, jnp.arange(nb)))
    return jnp.moveaxis(o, 0, 1).reshape(Bsz, S, MLA_WIDTH)


def conv_ffn(h, w_up, conv_w, conv_b, w_down):
    up = causal_dwconv(h @ w_up, conv_w, conv_b)
    gate, val = jnp.split(up, 2, axis=-1)
    return (jax.nn.silu(gate) * val) @ w_down


def setup_inputs(seed: int = 0) -> dict:
    key = jax.random.key(seed)
    ks = jax.random.split(key, 24)
    f32 = jnp.float32

    def nrm(k, shape, scale):
        return jax.random.normal(k, shape, f32) * scale

    def gain(k, shape):
        return 1.0 + 0.02 * jax.random.normal(k, shape, f32)

    x = jax.random.normal(ks[0], (BATCH, SEQ, D_MODEL), f32)
    offsets = jax.random.randint(ks[1], (BATCH, 1), 0, 1024, dtype=jnp.int32)
    positions = (offsets + jnp.arange(SEQ, dtype=jnp.int32)[None, :]).astype(jnp.int32)
    u_dt = jax.random.uniform(ks[2], (DEPTH, SSD_HEADS), f32)
    dt0 = jnp.exp(u_dt * (math.log(DT_MAX) - math.log(DT_MIN)) + math.log(DT_MIN))
    dt_bias = dt0 + jnp.log(-jnp.expm1(-dt0))
    a_log = jnp.log(jax.random.uniform(ks[3], (DEPTH, SSD_HEADS), f32, 1.0, 16.0))
    return {
        "x": x,
        "positions": positions,
        "attn_norm": gain(ks[4], (DEPTH, D_MODEL)),
        "w_in": nrm(ks[5], (DEPTH, D_MODEL, IN_COLS), D_MODEL ** -0.5),
        "ssd_conv_w": nrm(ks[6], (DEPTH, SSD_CONV, SSD_CONV_CH), SSD_CONV ** -0.5),
        "ssd_conv_b": nrm(ks[7], (DEPTH, SSD_CONV_CH), 0.02),
        "ssd_dt_bias": dt_bias,
        "ssd_a_log": a_log,
        "ssd_d": 1.0 + 0.1 * jax.random.normal(ks[8], (DEPTH, SSD_HEADS), f32),
        "ssd_norm": gain(ks[9], (DEPTH, SSD_WIDTH)),
        "pool_w": nrm(ks[10], (DEPTH, POOL_GROUPS, POOL_GROUP_DIM, POOL_GROUP_DIM), POOL_GROUP_DIM ** -0.5),
        "pool_scale": gain(ks[11], (DEPTH, POOL_WIDTH)),
        "mla_q_norm": gain(ks[12], (DEPTH, MLA_Q_RANK)),
        "mla_w_uq": nrm(ks[13], (DEPTH, MLA_Q_RANK, MLA_HEADS * MLA_QK), MLA_Q_RANK ** -0.5),
        "mla_kv_norm": gain(ks[14], (DEPTH, MLA_KV_RANK)),
        "mla_w_ukv": nrm(ks[15], (DEPTH, MLA_KV_RANK, MLA_HEADS * (MLA_NOPE + MLA_V)), MLA_KV_RANK ** -0.5),
        "w_out": nrm(ks[16], (DEPTH, MIX_WIDTH, D_MODEL), MIX_WIDTH ** -0.5),
        "ffn_norm": gain(ks[17], (DEPTH, D_MODEL)),
        "ffn_w_up": nrm(ks[18], (DEPTH, D_MODEL, 2 * D_FF), D_MODEL ** -0.5),
        "ffn_conv_w": nrm(ks[19], (DEPTH, FFN_CONV, 2 * D_FF), FFN_CONV ** -0.5),
        "ffn_conv_b": nrm(ks[20], (DEPTH, 2 * D_FF), 0.02),
        "ffn_w_down": nrm(ks[21], (DEPTH, D_FF, D_MODEL), D_FF ** -0.5),
        "final_norm": gain(ks[22], (D_MODEL,)),
    }


def reference(x, positions, attn_norm, w_in, ssd_conv_w, ssd_conv_b, ssd_dt_bias, ssd_a_log,
              ssd_d, ssd_norm, pool_w, pool_scale, mla_q_norm, mla_w_uq, mla_kv_norm, mla_w_ukv,
              w_out, ffn_norm, ffn_w_up, ffn_conv_w, ffn_conv_b, ffn_w_down, final_norm):
    cos, sin = rope_tables(positions)
    splits = [int(s) for s in np.cumsum(IN_SIZES)[:-1]]
    for l in range(DEPTH):
        h = rmsnorm(x, attn_norm[l])
        proj = h @ w_in[l]
        z, xbc, dt_raw, u, c_q, c_kv, k_pe = jnp.split(proj, splits, axis=-1)
        y_ssd = ssd_mixer(z, xbc, dt_raw, ssd_conv_w[l], ssd_conv_b[l], ssd_dt_bias[l],
                          ssd_a_log[l], ssd_d[l], ssd_norm[l])
        y_pool = pool_mixer(u, pool_w[l], pool_scale[l])
        y_mla = mla_mixer(c_q, c_kv, k_pe, cos, sin, mla_q_norm[l], mla_w_uq[l],
                          mla_kv_norm[l], mla_w_ukv[l])
        x = x + jnp.concatenate([y_ssd, y_pool, y_mla], axis=-1) @ w_out[l]
        h = rmsnorm(x, ffn_norm[l])
        x = x + conv_ffn(h, ffn_w_up[l], ffn_conv_w[l], ffn_conv_b[l], ffn_w_down[l])
    return rmsnorm(x, final_norm)
```

```cpp
#include <hip/hip_runtime.h>
#include <hip/hip_cooperative_groups.h>
#include <cstdio>
#include <cstdint>
namespace cg = cooperative_groups;
namespace pg8 {
#define PG8_LAS __attribute__((address_space(3)))
typedef unsigned short bf16_t;
typedef short bf16x8 __attribute__((ext_vector_type(8)));
typedef float f32x4 __attribute__((ext_vector_type(4)));
typedef unsigned u32x4 __attribute__((ext_vector_type(4)));
constexpr int BM = 256, BK = 64, HALF = 128, HTB = HALF * BK * 2  , STAGE_BYTES = 8 * HTB, NXCD = 8, WGM = 8;

__host__ __device__ __forceinline__ int lds_byte(int r, int c) { const int st = (r >> 4) * 2 + (c >> 5), rr = r & 15, cc = c & 31, ob = rr * 64 + cc * 2; return st * 1024 + (ob ^ (((ob >> 9) & 1) << 5)); }
__host__ __device__ __forceinline__ void stage_rc(int b, int& R, int& C) { const int st = b / 1024, sb = b % 1024, swz = sb ^ (((sb >> 9) & 1) << 5); R = (st >> 1) * 16 + swz / 64; C = (st & 1) * 32 + (swz % 64) / 2; }
__host__ __device__ __forceinline__ int perm32(int rho) { const int n = rho >> 4, i = rho & 15; return 8 * (i >> 2) + 4 * n + (i & 3); }

struct Unit { int pm, pn; };
struct Gemm { const bf16_t* A; const bf16_t* Bt; int M, N, K; };

struct StaticOrder {
    int nM, nN, nwg, G, c, rev;
    __host__ __device__ void init(int M, int N, int G_, int c_, int rev_ = 0) { nM = M / BM; nN = N / BM; nwg = nM * nN; G = G_; c = c_; rev = rev_; }
    __host__ __device__ bool next(int i, Unit& u) const {
        const long L = (long)i * G + c; if (L >= nwg) return false;
        int wgid = (int)L; { const int q = nwg / NXCD, r = nwg % NXCD, xcd = wgid % NXCD, off = wgid / NXCD; wgid = (xcd < r ? xcd * (q + 1) : r * (q + 1) + (xcd - r) * q) + off; }
        const int nig = WGM * nN, gid = wgid / nig, fm = gid * WGM, gsz = (nM - fm) < WGM ? (nM - fm) : WGM;
        u.pm = fm + ((wgid % nig) % gsz); u.pn = (wgid % nig) / gsz; if (rev) u.pm = nM - 1 - u.pm; return true;
    }
    __device__ __forceinline__ void a_ready(const Unit&) const {}
    __device__ __forceinline__ void done(const Unit&) const {}
};

__device__ __forceinline__ unsigned cvt_pk_bf16(float lo, float hi) { unsigned r; asm volatile("v_cvt_pk_bf16_f32 %0, %1, %2" : "=v"(r) : "v"(lo), "v"(hi)); return r; }
typedef float f32x2 __attribute__((ext_vector_type(2)));
typedef unsigned u32x2 __attribute__((ext_vector_type(2)));
__device__ __forceinline__ float fast_silu(float v) { return v * __builtin_amdgcn_rcpf(1.0f + __builtin_amdgcn_exp2f(-1.4426950408889634f * v)); }

struct EpiStoreBf16 {
    static constexpr bool PERM = true, AFTER_DRAIN = false;
    bf16_t* O; int ldc;
    __device__ __forceinline__ void operator()(const f32x4 (&acc)[2][2][4][2], const Unit& u, int wr, int wc, int fr, int fq) const {
        const int row0 = u.pm * BM + wr * 64 + fr; const int col0 = u.pn * BM + wc * 32 + 8 * fq;
#pragma unroll
        for (int ai = 0; ai < 2; ++ai)
#pragma unroll
            for (int m = 0; m < 4; ++m) { bf16_t* rowp = O + (size_t)(row0 + ai * HALF + m * 16) * ldc + col0;
#pragma unroll
                for (int bj = 0; bj < 2; ++bj) { const f32x4 v0 = acc[ai][bj][m][0], v1 = acc[ai][bj][m][1];
                    u32x4 w; w.x = cvt_pk_bf16(v0[0], v0[1]); w.y = cvt_pk_bf16(v0[2], v0[3]); w.z = cvt_pk_bf16(v1[0], v1[1]); w.w = cvt_pk_bf16(v1[2], v1[3]);
                    *(u32x4*)(rowp + bj * HALF) = w; } }
    }
};
struct EpiResF32 {
    static constexpr bool PERM = false, AFTER_DRAIN = false;
    const float* base; float* out; int ldc;
    __device__ __forceinline__ void operator()(const f32x4 (&acc)[2][2][4][2], const Unit& u, int wr, int wc, int fr, int fq) const {
        const int row0 = u.pm * BM + wr * 64 + fr; const int col0 = u.pn * BM + wc * 32 + 4 * fq;
#pragma unroll
        for (int ai = 0; ai < 2; ++ai)
#pragma unroll
            for (int m = 0; m < 4; ++m) { const size_t off = (size_t)(row0 + ai * HALF + m * 16) * ldc + col0;
#pragma unroll
                for (int bj = 0; bj < 2; ++bj)
#pragma unroll
                    for (int n = 0; n < 2; ++n) { const f32x4 b = *(const f32x4*)(base + off + bj * HALF + n * 16); *(f32x4*)(out + off + bj * HALF + n * 16) = b + acc[ai][bj][m][n]; } }
    }
};
struct EpiQRope {
    static constexpr bool PERM = false, AFTER_DRAIN = false;
    bf16_t* O; int ldc; const float* cosT; const float* sinT; float qscale;
    __device__ __forceinline__ void operator()(const f32x4 (&acc)[2][2][4][2], const Unit& u, int wr, int wc, int fr, int fq) const {
        asm volatile("" : "+v"(fr), "+v"(fq));
        const int row0 = u.pm * BM + wr * 64 + fr;
#pragma unroll
        for (int ai = 0; ai < 2; ++ai)
#pragma unroll
            for (int m = 0; m < 4; ++m) { const int row = row0 + ai * HALF + m * 16;
                const f32x4 cs = *(const f32x4*)(cosT + (size_t)row * 16 + 4 * fq), sn = *(const f32x4*)(sinT + (size_t)row * 16 + 4 * fq);
#pragma unroll
                for (int bj = 0; bj < 2; ++bj) { const int cb = u.pn * BM + bj * HALF + wc * 32; const bool rp = ((cb >> 5) % 3) == 2;
                    f32x4 x1 = acc[ai][bj][m][0], x2 = acc[ai][bj][m][1];
                    if (rp) { const f32x4 a = x1 * cs - x2 * sn, b = x1 * sn + x2 * cs; x1 = a; x2 = b; }
                    x1 = x1 * qscale; x2 = x2 * qscale;
                    bf16_t* p = O + (size_t)row * ldc + cb + 4 * fq;
                    u32x2 w0, w1; w0.x = cvt_pk_bf16(x1[0], x1[1]); w0.y = cvt_pk_bf16(x1[2], x1[3]); w1.x = cvt_pk_bf16(x2[0], x2[1]); w1.y = cvt_pk_bf16(x2[2], x2[3]);
                    *(u32x2*)p = w0; *(u32x2*)(p + 16) = w1; }
                asm volatile("" ::: "memory"); }
    }
};
template <int CTRL> __device__ __forceinline__ float dpp_mov(float old, float src) {
    return __builtin_bit_cast(float, __builtin_amdgcn_update_dpp(__builtin_bit_cast(int, old), __builtin_bit_cast(int, src), CTRL, 0xF, 0xF, false));
}
template <int CTRL> __device__ __forceinline__ float ror_dpp(float src) { return __builtin_bit_cast(float, __builtin_amdgcn_mov_dpp(__builtin_bit_cast(int, src), CTRL, 0xF, 0xF, true)); }
struct EpiFfnConv {
    static constexpr bool PERM = true, AFTER_DRAIN = false;
    bf16_t* ACT; float* RAW; const float* cw; const float* cb;
    __device__ __forceinline__ void operator()(const f32x4 (&acc)[2][2][4][2], const Unit& u, int wr, int wc, int fr, int fq) const {
        asm volatile("" : "+v"(fr), "+v"(fq));
        const int rc0 = wc * 32 + 8 * fq;
        const int gch = u.pn * HALF + rc0;
        if (fr < 2 || fr >= 14) {
#pragma unroll
            for (int ai = 0; ai < 2; ++ai) {
                const int blk = (u.pm * BM + ai * HALF + wr * 64) >> 6;
                const int slot = fr < 2 ? fr : fr - 12;
                float* rp = RAW + ((size_t)blk * 4 + slot) * 5632 + u.pn * BM + rc0;
#pragma unroll
                for (int bj = 0; bj < 2; ++bj)
#pragma unroll
                    for (int n = 0; n < 2; ++n) *(f32x4*)(rp + bj * HALF + 4 * n) = (fr < 2) ? acc[ai][bj][0][n] : acc[ai][bj][3][n];
            }
        }
        asm volatile("" ::: "memory");
        const int row0 = u.pm * BM + wr * 64 + fr;
        const bool is15 = (fr == 15), ge14 = (fr >= 14);
#pragma unroll
        for (int n = 0; n < 2; ++n) {
            const int ch = gch + 4 * n;
            const float SG = -1.4426950408889634f, SV = -0.6931471805599453f;
            const f32x4 gw0 = *(const f32x4*)(cw + ch) * SG, gw1 = *(const f32x4*)(cw + 5632 + ch) * SG, gw2 = *(const f32x4*)(cw + 2 * 5632 + ch) * SG, gbb = *(const f32x4*)(cb + ch) * SG;
            const f32x4 vw0 = *(const f32x4*)(cw + 2816 + ch) * SV, vw1 = *(const f32x4*)(cw + 5632 + 2816 + ch) * SV, vw2 = *(const f32x4*)(cw + 2 * 5632 + 2816 + ch) * SV, vbb = *(const f32x4*)(cb + 2816 + ch) * SV;
#pragma unroll
            for (int ai = 0; ai < 2; ++ai)
#pragma unroll
                for (int m = 0; m < 4; ++m) {
                    const f32x4 gc = acc[ai][0][m][n], vc = acc[ai][1][m][n];
                    f32x4 gp = (f32x4){0.f, 0.f, 0.f, 0.f}, vp = gp; if (m > 0) { gp = acc[ai][0][m - 1][n]; vp = acc[ai][1][m - 1][n]; }
                    f32x4 gm1, gm2, vm1, vm2, gg, vv;
#pragma unroll
                    for (int j = 0; j < 4; ++j) { gm1[j] = is15 ? gp[j] : gc[j]; gm2[j] = ge14 ? gp[j] : gc[j]; vm1[j] = is15 ? vp[j] : vc[j]; vm2[j] = ge14 ? vp[j] : vc[j];
                        gg[j] = gbb[j] + gw2[j] * gc[j]; vv[j] = vbb[j] + vw2[j] * vc[j]; }
                    float g0 = gg[0], g1 = gg[1], g2 = gg[2], g3 = gg[3], v0 = vv[0], v1 = vv[1], v2 = vv[2], v3 = vv[3];
                    asm volatile("s_nop 1\n\t"
                                 "v_fmac_f32_dpp %0, %8, %9 row_ror:1 row_mask:0xf bank_mask:0xf\n\tv_fmac_f32_dpp %1, %10, %11 row_ror:1 row_mask:0xf bank_mask:0xf\n\t"
                                 "v_fmac_f32_dpp %2, %12, %13 row_ror:1 row_mask:0xf bank_mask:0xf\n\tv_fmac_f32_dpp %3, %14, %15 row_ror:1 row_mask:0xf bank_mask:0xf\n\t"
                                 "v_fmac_f32_dpp %4, %16, %17 row_ror:1 row_mask:0xf bank_mask:0xf\n\tv_fmac_f32_dpp %5, %18, %19 row_ror:1 row_mask:0xf bank_mask:0xf\n\t"
                                 "v_fmac_f32_dpp %6, %20, %21 row_ror:1 row_mask:0xf bank_mask:0xf\n\tv_fmac_f32_dpp %7, %22, %23 row_ror:1 row_mask:0xf bank_mask:0xf"
                                 : "+v"(g0), "+v"(g1), "+v"(g2), "+v"(g3), "+v"(v0), "+v"(v1), "+v"(v2), "+v"(v3)
                                 : "v"(gm1[0]), "v"(gw1[0]), "v"(gm1[1]), "v"(gw1[1]), "v"(gm1[2]), "v"(gw1[2]), "v"(gm1[3]), "v"(gw1[3]),
                                   "v"(vm1[0]), "v"(vw1[0]), "v"(vm1[1]), "v"(vw1[1]), "v"(vm1[2]), "v"(vw1[2]), "v"(vm1[3]), "v"(vw1[3]));
                    asm volatile("s_nop 1\n\t"
                                 "v_fmac_f32_dpp %0, %8, %9 row_ror:2 row_mask:0xf bank_mask:0xf\n\tv_fmac_f32_dpp %1, %10, %11 row_ror:2 row_mask:0xf bank_mask:0xf\n\t"
                                 "v_fmac_f32_dpp %2, %12, %13 row_ror:2 row_mask:0xf bank_mask:0xf\n\tv_fmac_f32_dpp %3, %14, %15 row_ror:2 row_mask:0xf bank_mask:0xf\n\t"
                                 "v_fmac_f32_dpp %4, %16, %17 row_ror:2 row_mask:0xf bank_mask:0xf\n\tv_fmac_f32_dpp %5, %18, %19 row_ror:2 row_mask:0xf bank_mask:0xf\n\t"
                                 "v_fmac_f32_dpp %6, %20, %21 row_ror:2 row_mask:0xf bank_mask:0xf\n\tv_fmac_f32_dpp %7, %22, %23 row_ror:2 row_mask:0xf bank_mask:0xf"
                                 : "+v"(g0), "+v"(g1), "+v"(g2), "+v"(g3), "+v"(v0), "+v"(v1), "+v"(v2), "+v"(v3)
                                 : "v"(gm2[0]), "v"(gw0[0]), "v"(gm2[1]), "v"(gw0[1]), "v"(gm2[2]), "v"(gw0[2]), "v"(gm2[3]), "v"(gw0[3]),
                                   "v"(vm2[0]), "v"(vw0[0]), "v"(vm2[1]), "v"(vw0[1]), "v"(vm2[2]), "v"(vw0[2]), "v"(vm2[3]), "v"(vw0[3]));
                    f32x4 a;
                    a[0] = g0 * v0 * __builtin_amdgcn_rcpf(1.0f + __builtin_amdgcn_exp2f(g0)); a[1] = g1 * v1 * __builtin_amdgcn_rcpf(1.0f + __builtin_amdgcn_exp2f(g1));
                    a[2] = g2 * v2 * __builtin_amdgcn_rcpf(1.0f + __builtin_amdgcn_exp2f(g2)); a[3] = g3 * v3 * __builtin_amdgcn_rcpf(1.0f + __builtin_amdgcn_exp2f(g3));
                    u32x2 w; w.x = cvt_pk_bf16(a[0], a[1]); w.y = cvt_pk_bf16(a[2], a[3]);
                    *(u32x2*)(ACT + (size_t)(row0 + ai * HALF + m * 16) * 2816 + ch) = w;
                }
            asm volatile("" ::: "memory");
        }
    }
};
template <class Epi, class Sched, bool ALIGN_EPI = false, bool SP2 = false>
__device__ __forceinline__ void gemm_phase(PG8_LAS unsigned char* lds, const Gemm g, const Sched& S, const Epi& E, const int tid_in) {
    int tid_ = tid_in; asm volatile("" : "+v"(tid_)); const int tid = tid_, wid = __builtin_amdgcn_readfirstlane(tid >> 6), lane = tid & 63, wr = wid >> 2, wc = wid & 3, fr = lane & 15, fq = lane >> 4;
    int K_ = g.K; asm volatile("" : "+s"(K_)); const int K = K_, nt = K / BK;
    unsigned voffA[2], voffB[2];
#pragma unroll
    for (int i = 0; i < 2; ++i) { int R, C; stage_rc(tid * 16 + i * 8192, R, C); const int Rb = Epi::PERM ? ((R & ~31) + perm32(R & 31)) : R;
        voffA[i] = (unsigned)(R * K + C) * 2u; voffB[i] = (unsigned)(Rb * K + C) * 2u; }
    const size_t kstep = (size_t)(BK * 2);
    const size_t hstep = (size_t)HALF * K * 2;
    const size_t tstep = 2 * hstep;
    const unsigned ldsw = (unsigned)wid * 1024u;
    const int aoff = lds_byte(wr * 64 + fr, fq * 8), boff = lds_byte(wc * 32 + fr, fq * 8);
#define PG8_SA(b, h) (((b) * 2 + (h)) * HTB)
#define PG8_SB(b, h) ((4 + (b) * 2 + (h)) * HTB)
#define PG8_STAGE(bufoff, gbase, voff) do { _Pragma("unroll") for (int _i = 0; _i < 2; ++_i) \
        __builtin_amdgcn_global_load_lds((const unsigned*)((const char*)(gbase) + (voff)[_i]), (PG8_LAS unsigned*)(lds + (bufoff) + ldsw + _i * 8192), 16, 0, 0); } while (0)
#define PG8_LDA(dst, b, h) do { _Pragma("unroll") for (int m = 0; m < 4; ++m) _Pragma("unroll") for (int k = 0; k < 2; ++k) dst[m][k] = *(const PG8_LAS bf16x8*)(lds + PG8_SA(b, h) + aoff + m * 2048 + k * 1024); } while (0)
#define PG8_LDB(dst, b, h) do { _Pragma("unroll") for (int n = 0; n < 2; ++n) _Pragma("unroll") for (int k = 0; k < 2; ++k) dst[n][k] = *(const PG8_LAS bf16x8*)(lds + PG8_SB(b, h) + boff + n * 2048 + k * 1024); } while (0)
#define PG8_MMA(ai, bj, At, Bt) do { __builtin_amdgcn_s_setprio(1); _Pragma("unroll") for (int m = 0; m < 4; ++m) _Pragma("unroll") for (int n = 0; n < 2; ++n) _Pragma("unroll") for (int k = 0; k < 2; ++k) \
        acc[ai][bj][m][n] = __builtin_amdgcn_mfma_f32_16x16x32_bf16(Bt[n][k], At[m][k], acc[ai][bj][m][n], 0, 0, 0); __builtin_amdgcn_s_setprio(0); } while (0)
#define PG8_WAIT_V(n) asm volatile("s_waitcnt vmcnt(" #n ")" ::: "memory")
#define PG8_WAIT_L(n) asm volatile("s_waitcnt lgkmcnt(" #n ")" ::: "memory")
#define PG8_BAR __builtin_amdgcn_s_barrier()
#define PG8_SCHED __builtin_amdgcn_sched_barrier(0)
    Unit cur, nxt; int ui = 0;
    if (!S.next(0, cur)) return;
    f32x4 acc[2][2][4][2];
#pragma unroll
    for (int a = 0; a < 2; ++a)
#pragma unroll
        for (int b = 0; b < 2; ++b)
#pragma unroll
            for (int m = 0; m < 4; ++m)
#pragma unroll
                for (int n = 0; n < 2; ++n) acc[a][b][m][n] = (f32x4){0.f, 0.f, 0.f, 0.f};
    bf16x8 At[4][2], B0[2][2], B1[2][2];
    const char* cA = (const char*)g.A + (size_t)cur.pm * tstep; const char* cB = (const char*)g.Bt + (size_t)cur.pn * tstep;
    S.a_ready(cur);
    if constexpr (SP2) {
        PG8_STAGE(PG8_SB(0, 0), cB, voffB); PG8_STAGE(PG8_SB(0, 1), cB + hstep, voffB); PG8_STAGE(PG8_SA(0, 0), cA, voffA); PG8_STAGE(PG8_SA(0, 1), cA + hstep, voffA);
        if (wr == 1) PG8_BAR;
        PG8_WAIT_V(2); PG8_BAR;
        PG8_STAGE(PG8_SB(1, 0), cB + kstep, voffB); PG8_STAGE(PG8_SA(1, 0), cA + kstep, voffA); PG8_STAGE(PG8_SB(1, 1), cB + hstep + kstep, voffB);
        PG8_WAIT_V(6); PG8_BAR;
    } else {
        PG8_STAGE(PG8_SB(0, 0), cB, voffB); PG8_STAGE(PG8_SA(0, 0), cA, voffA); PG8_STAGE(PG8_SB(0, 1), cB + hstep, voffB); PG8_STAGE(PG8_SA(0, 1), cA + hstep, voffA);
        if (wr == 1) PG8_BAR;
        PG8_WAIT_V(4); PG8_BAR;
        PG8_STAGE(PG8_SB(1, 0), cB + kstep, voffB); PG8_STAGE(PG8_SA(1, 0), cA + kstep, voffA); PG8_STAGE(PG8_SB(1, 1), cB + hstep + kstep, voffB);
        PG8_WAIT_V(6); PG8_BAR;
    }
    for (;;) {
        const bool has_next = S.next(ui + 1, nxt);
        const char* nA = has_next ? (const char*)g.A + (size_t)nxt.pm * tstep : cA; const char* nB = has_next ? (const char*)g.Bt + (size_t)nxt.pn * tstep : cB;
        for (int t = 0; t < nt; t += 2) {
            const bool last = (t == nt - 2);
            const char* a1 = cA + (size_t)(t + 1) * kstep;
            const char* a2 = last ? nA : cA + (size_t)(t + 2) * kstep; const char* b2 = last ? nB : cB + (size_t)(t + 2) * kstep;
            const char* a3 = a2 + kstep; const char* b3 = b2 + kstep;
            if (last && has_next) S.a_ready(nxt);
            if constexpr (SP2) {
            PG8_LDB(B0, 0, 0); PG8_LDB(B1, 0, 1); PG8_SCHED; PG8_LDA(At, 0, 0); PG8_STAGE(PG8_SA(1, 1), a1 + hstep, voffA);
            PG8_WAIT_V(8); PG8_WAIT_L(0); PG8_BAR; PG8_MMA(0, 0, At, B0); PG8_MMA(0, 1, At, B1); PG8_BAR; PG8_SCHED;
            PG8_LDA(At, 0, 1); PG8_STAGE(PG8_SB(0, 0), b2, voffB); PG8_STAGE(PG8_SB(0, 1), b2 + hstep, voffB); PG8_STAGE(PG8_SA(0, 0), a2, voffA);
            PG8_WAIT_V(8); PG8_WAIT_L(0); PG8_BAR; PG8_MMA(1, 0, At, B0); PG8_MMA(1, 1, At, B1); PG8_BAR; PG8_SCHED;
            PG8_LDB(B0, 1, 0); PG8_LDB(B1, 1, 1); PG8_SCHED; PG8_LDA(At, 1, 0); PG8_STAGE(PG8_SA(0, 1), a2 + hstep, voffA);
            PG8_WAIT_V(8); PG8_WAIT_L(0); PG8_BAR; PG8_MMA(0, 0, At, B0); PG8_MMA(0, 1, At, B1); PG8_BAR; PG8_SCHED;
            PG8_LDA(At, 1, 1); PG8_STAGE(PG8_SB(1, 0), b3, voffB); PG8_STAGE(PG8_SB(1, 1), b3 + hstep, voffB); PG8_STAGE(PG8_SA(1, 0), a3, voffA);
            PG8_WAIT_V(8); PG8_WAIT_L(0); PG8_BAR; PG8_MMA(1, 0, At, B0); PG8_MMA(1, 1, At, B1); PG8_BAR; PG8_SCHED;
            } else {
            PG8_LDB(B0, 0, 0); PG8_SCHED; PG8_LDA(At, 0, 0); PG8_STAGE(PG8_SA(1, 1), a1 + hstep, voffA);
            PG8_WAIT_L(8); PG8_BAR; PG8_WAIT_L(0); PG8_MMA(0, 0, At, B0); PG8_BAR; PG8_SCHED;
            PG8_LDB(B1, 0, 1); PG8_STAGE(PG8_SB(0, 0), b2, voffB);
            PG8_BAR; PG8_WAIT_L(0); PG8_MMA(0, 1, At, B1); PG8_BAR;
            PG8_LDA(At, 0, 1); PG8_STAGE(PG8_SA(0, 0), a2, voffA);
            PG8_BAR; PG8_WAIT_L(0); PG8_MMA(1, 0, At, B0); PG8_BAR; PG8_SCHED;
            PG8_STAGE(PG8_SB(0, 1), b2 + hstep, voffB);
            PG8_WAIT_V(6); PG8_BAR; PG8_MMA(1, 1, At, B1); PG8_BAR;
            PG8_LDB(B0, 1, 0); PG8_SCHED; PG8_LDA(At, 1, 0); PG8_STAGE(PG8_SA(0, 1), a2 + hstep, voffA);
            PG8_WAIT_L(8); PG8_BAR; PG8_WAIT_L(0); PG8_MMA(0, 0, At, B0); PG8_BAR; PG8_SCHED;
            PG8_LDB(B1, 1, 1); PG8_STAGE(PG8_SB(1, 0), b3, voffB);
            PG8_BAR; PG8_WAIT_L(0); PG8_MMA(0, 1, At, B1); PG8_BAR;
            PG8_LDA(At, 1, 1); PG8_STAGE(PG8_SA(1, 0), a3, voffA);
            PG8_BAR; PG8_WAIT_L(0); PG8_MMA(1, 0, At, B0); PG8_BAR; PG8_SCHED;
            PG8_STAGE(PG8_SB(1, 1), b3 + hstep, voffB);
            PG8_WAIT_V(6); PG8_BAR; PG8_MMA(1, 1, At, B1); PG8_BAR;
            }
        }
        if constexpr (ALIGN_EPI) { if (wr == 0) PG8_BAR; }
        if constexpr (!Epi::AFTER_DRAIN) { E(acc, cur, wr, wc, fr, fq); S.done(cur); }
        if (!has_next) break;
#pragma unroll
        for (int a = 0; a < 2; ++a)
#pragma unroll
            for (int b = 0; b < 2; ++b)
#pragma unroll
                for (int m = 0; m < 4; ++m)
#pragma unroll
                    for (int n = 0; n < 2; ++n) acc[a][b][m][n] = (f32x4){0.f, 0.f, 0.f, 0.f};
        cur = nxt; cA = nA; cB = nB; ++ui;
        if constexpr (ALIGN_EPI) { if (wr == 1) PG8_BAR; }
    }
    PG8_WAIT_V(0);
    if constexpr (!ALIGN_EPI) { if (wr == 0) PG8_BAR; }
    PG8_BAR;
    if constexpr (Epi::AFTER_DRAIN) { E.fused(acc, cur, wr, wc, fr, fq, lds, wid, lane); S.done(cur); }
#undef PG8_SA
#undef PG8_SB
#undef PG8_STAGE
#undef PG8_LDA
#undef PG8_LDB
#undef PG8_MMA
#undef PG8_WAIT_V
#undef PG8_WAIT_L
#undef PG8_BAR
#undef PG8_SCHED
}
}
constexpr int NB = 16, SEQ = 4096, DM = 1024, MROWS = NB * SEQ, DEPTH = 2;
constexpr int NIN = 3760, NINP = 3840;
constexpr int COL_Z = 0, COL_XBC = 1024, COL_DT = 2560, COL_U = 2576, COL_CQ = 3088, COL_CKV = 3472, COL_KPE = 3728;
constexpr int DFF = 2816, MIXW = 2048;
constexpr float EPS = 1e-6f;
constexpr size_t MiB = 1u << 20;
constexpr size_t WS_H = 0, WS_CQN = 0, WS_CKVN = 48 * MiB, WS_KPE = 80 * MiB;
constexpr size_t WS_PROJ = 128 * MiB, WS_QB = WS_PROJ, WS_KVB = WS_PROJ + 96 * MiB, WS_ACT = WS_PROJ;
constexpr size_t WS_MIX = 608 * MiB, WS_RAW = WS_MIX;
constexpr size_t WS_W = 864 * MiB, W_LAYER = 30 * MiB;
constexpr size_t WO_IN = 0, WO_OUT = WO_IN + (size_t)NINP * 1024 * 2, WO_UP = WO_OUT + (size_t)1024 * 2048 * 2, WO_DOWN = WO_UP + (size_t)5632 * 1024 * 2,
                 WO_UQ = WO_DOWN + (size_t)1024 * 2816 * 2, WO_UKV = WO_UQ + (size_t)768 * 384 * 2, WO_POOL = WO_UKV + (size_t)1024 * 256 * 2, WO_END = WO_POOL + (size_t)4 * 128 * 128 * 2;
static_assert(WO_END <= W_LAYER, "weights fit");
constexpr size_t WS_COS = 926 * MiB, WS_SIN = 930 * MiB, WS_CTL = 934 * MiB, WS_BC = 935 * MiB  , WS_END = 999 * MiB;
constexpr int MISC_OFF = 140000;
constexpr int LDS_BYTES = 147456;
constexpr int NTHR = 512;

typedef unsigned short bf16;
typedef unsigned v4u __attribute__((ext_vector_type(4)));
typedef unsigned v2u __attribute__((ext_vector_type(2)));
typedef float f32x4 __attribute__((ext_vector_type(4)));
typedef float f32x16 __attribute__((ext_vector_type(16)));
typedef short bf16x8 __attribute__((ext_vector_type(8)));
typedef short s16x4 __attribute__((ext_vector_type(4)));
#define LAS __attribute__((address_space(3)))
#define LBAR() asm volatile("s_waitcnt lgkmcnt(0)\n\ts_barrier" ::: "memory")

__device__ __forceinline__ unsigned f2bf(float f) { unsigned u = __builtin_bit_cast(unsigned, f); return (u + 0x7fffu + ((u >> 16) & 1u)) >> 16; }
__device__ __forceinline__ unsigned pk2(float lo, float hi) { return pg8::cvt_pk_bf16(lo, hi); }
__device__ __forceinline__ float bflo(unsigned w) { return __builtin_bit_cast(float, w << 16); }
__device__ __forceinline__ float bfhi(unsigned w) { return __builtin_bit_cast(float, w & 0xffff0000u); }
__device__ __forceinline__ float bf1(bf16 h) { return __builtin_bit_cast(float, (unsigned)h << 16); }
__device__ __forceinline__ float wave_sum(float v) {
#pragma unroll
    for (int o = 1; o < 64; o <<= 1) v += __shfl_xor(v, o);
    return v;
}
__device__ __forceinline__ float silu_f(float v) { return v / (1.0f + __expf(-v)); }

struct Params {
    const float* x; const int* pos; const float* attn_norm; const float* w_in; const float* ssd_conv_w; const float* ssd_conv_b; const float* ssd_dt_bias; const float* ssd_a_log;
    const float* ssd_d; const float* ssd_norm; const float* pool_w; const float* pool_scale; const float* q_norm; const float* w_uq; const float* kv_norm; const float* w_ukv;
    const float* w_out; const float* ffn_norm; const float* w_up; const float* ffn_conv_w; const float* ffn_conv_b; const float* w_down; const float* final_norm;
    float* out; unsigned char* ws;
};

__device__ __forceinline__ void transpose_item(const float* W, int K, int N, bf16* WT, int mode, float* scr, int item, int lane, int nblk) {
    const int kb = item / nblk, nb = item % nblk, k0 = 64 * kb, n0 = 32 * nb;
    { const int n4 = n0 + 4 * (lane & 7), kr = lane >> 3; f32x4 v[8];
#pragma unroll
      for (int i = 0; i < 8; ++i) v[i] = (n4 < N) ? *(const f32x4*)(W + (size_t)(k0 + 8 * i + kr) * N + n4) : (f32x4){0.f, 0.f, 0.f, 0.f};
#pragma unroll
      for (int i = 0; i < 8; ++i) { float* d = scr + (8 * i + kr) * 33 + 4 * (lane & 7); d[0] = v[i][0]; d[1] = v[i][1]; d[2] = v[i][2]; d[3] = v[i][3]; } }
    asm volatile("s_waitcnt lgkmcnt(0)" ::: "memory");
    const int c = lane & 7;
#pragma unroll
    for (int j = 0; j < 4; ++j) { const int n = (lane >> 3) + 8 * j; const float* s = scr + (8 * c) * 33 + n;
        v4u o; o.x = pk2(s[0 * 33], s[1 * 33]); o.y = pk2(s[2 * 33], s[3 * 33]); o.z = pk2(s[4 * 33], s[5 * 33]); o.w = pk2(s[6 * 33], s[7 * 33]);
        int gn = n0 + n; int dr = gn;
        if (mode == 1) { dr = (gn < DFF) ? ((gn >> 7) * 256 + (gn & 127)) : (((gn - DFF) >> 7) * 256 + 128 + ((gn - DFF) & 127)); }
        *(v4u*)(WT + (size_t)dr * K + k0 + 8 * c) = o; }
    asm volatile("s_waitcnt lgkmcnt(0)" ::: "memory");
}
__device__ __forceinline__ void phase_weights(const Params& P, unsigned char* lds, int gw, int ngw, int lane, int wave) {
    float* scr = (float*)(lds + wave * 16384);
    for (int l = 0; l < DEPTH; ++l) {
        unsigned char* wb = P.ws + WS_W + (size_t)l * W_LAYER;
        const int i_in = (1024 / 64) * (NINP / 32), i_out = (2048 / 64) * (1024 / 32), i_up = (1024 / 64) * (5632 / 32), i_dn = (2816 / 64) * (1024 / 32), i_uq = (384 / 64) * (768 / 32), i_ukv = (256 / 64) * (1024 / 32), i_pool = 4 * 8;
        const int tot = i_in + i_out + i_up + i_dn + i_uq + i_ukv + i_pool;
        for (int it = gw; it < tot; it += ngw) {
            int r = it;
            if (r < i_in) { transpose_item(P.w_in + (size_t)l * 1024 * NIN, 1024, NIN, (bf16*)(wb + WO_IN), 0, scr, r, lane, NINP / 32); continue; } r -= i_in;
            if (r < i_out) { transpose_item(P.w_out + (size_t)l * 2048 * 1024, 2048, 1024, (bf16*)(wb + WO_OUT), 0, scr, r, lane, 1024 / 32); continue; } r -= i_out;
            if (r < i_up) { transpose_item(P.w_up + (size_t)l * 1024 * 5632, 1024, 5632, (bf16*)(wb + WO_UP), 1, scr, r, lane, 5632 / 32); continue; } r -= i_up;
            if (r < i_dn) { transpose_item(P.w_down + (size_t)l * 2816 * 1024, 2816, 1024, (bf16*)(wb + WO_DOWN), 0, scr, r, lane, 1024 / 32); continue; } r -= i_dn;
            if (r < i_uq) { transpose_item(P.w_uq + (size_t)l * 384 * 768, 384, 768, (bf16*)(wb + WO_UQ), 0, scr, r, lane, 768 / 32); continue; } r -= i_uq;
            if (r < i_ukv) { transpose_item(P.w_ukv + (size_t)l * 256 * 1024, 256, 1024, (bf16*)(wb + WO_UKV), 0, scr, r, lane, 1024 / 32); continue; } r -= i_ukv;
            transpose_item(P.pool_w + ((size_t)l * 4 + (r >> 3)) * 128 * 128, 128, 128, (bf16*)(wb + WO_POOL) + (size_t)(r >> 3) * 128 * 128, 0, scr, r & 7, lane, 4);
        }
    }
}
__constant__ double INV_FREQ[16] = {1.0, 0.5623413251903491, 0.31622776601683794, 0.1778279410038923, 0.1, 0.05623413251903491, 0.03162277660168379, 0.01778279410038923,
                                    0.01, 0.005623413251903491, 0.0031622776601683794, 0.0017782794100389228, 0.001, 0.0005623413251903491, 0.00031622776601683794, 0.00017782794100389227};
__device__ __forceinline__ void phase_rope_table(const Params& P, int gtid, int ngt) {
    float* cosT = (float*)(P.ws + WS_COS); float* sinT = (float*)(P.ws + WS_SIN);
    for (int i = gtid; i < MROWS * 16; i += ngt) {
        const int row = i >> 4, f = i & 15;
        const double ang = (double)P.pos[row] * INV_FREQ[f];
        const double k = __builtin_rint(ang * 0.15915494309189535);
        const float r = (float)(ang - k * 6.283185307179586);
        cosT[i] = __cosf(r) ; sinT[i] = __sinf(r);
    }
}
template <int NR> __device__ __forceinline__ void rms_rows_bf16(const float* x, const float* w, bf16* o, int m0, int mstride, int lane) {
    f32x4 v[NR][4]; float s[NR];
#pragma unroll
    for (int r = 0; r < NR; ++r) { const f32x4* xr = (const f32x4*)(x + (size_t)(m0 + r * mstride) * DM) + lane;
#pragma unroll
        for (int j = 0; j < 4; ++j) v[r][j] = xr[64 * j]; }
#pragma unroll
    for (int r = 0; r < NR; ++r) { float t = 0.f;
#pragma unroll
        for (int j = 0; j < 4; ++j) t += (v[r][j].x * v[r][j].x + v[r][j].y * v[r][j].y) + (v[r][j].z * v[r][j].z + v[r][j].w * v[r][j].w);
        s[r] = t; }
#pragma unroll
    for (int o2 = 1; o2 < 64; o2 <<= 1) {
#pragma unroll
        for (int r = 0; r < NR; ++r) s[r] += __shfl_xor(s[r], o2); }
    const f32x4* wr = (const f32x4*)w + lane;
    f32x4 g[4];
#pragma unroll
    for (int j = 0; j < 4; ++j) g[j] = wr[64 * j];
#pragma unroll
    for (int r = 0; r < NR; ++r) { const float rstd = 1.0f / sqrtf(s[r] * (1.f / DM) + EPS);
        unsigned long long* o8 = (unsigned long long*)(o + (size_t)(m0 + r * mstride) * DM) + lane;
#pragma unroll
        for (int j = 0; j < 4; ++j) o8[64 * j] = (unsigned long long)pk2(v[r][j].x * rstd * g[j].x, v[r][j].y * rstd * g[j].y) | ((unsigned long long)pk2(v[r][j].z * rstd * g[j].z, v[r][j].w * rstd * g[j].w) << 32); }
}
template <int NR> __device__ __forceinline__ void rms_rows_f32(float* x, const float* w, int m0, int mstride, int lane) {
    f32x4 v[NR][4]; float s[NR];
#pragma unroll
    for (int r = 0; r < NR; ++r) { const f32x4* xr = (const f32x4*)(x + (size_t)(m0 + r * mstride) * DM) + lane;
#pragma unroll
        for (int j = 0; j < 4; ++j) v[r][j] = xr[64 * j]; }
#pragma unroll
    for (int r = 0; r < NR; ++r) { float t = 0.f;
#pragma unroll
        for (int j = 0; j < 4; ++j) t += (v[r][j].x * v[r][j].x + v[r][j].y * v[r][j].y) + (v[r][j].z * v[r][j].z + v[r][j].w * v[r][j].w);
        s[r] = t; }
#pragma unroll
    for (int o2 = 1; o2 < 64; o2 <<= 1) {
#pragma unroll
        for (int r = 0; r < NR; ++r) s[r] += __shfl_xor(s[r], o2); }
    const f32x4* wr = (const f32x4*)w + lane;
    f32x4 g[4];
#pragma unroll
    for (int j = 0; j < 4; ++j) g[j] = wr[64 * j];
#pragma unroll
    for (int r = 0; r < NR; ++r) { const float rstd = 1.0f / sqrtf(s[r] * (1.f / DM) + EPS);
        f32x4* xo = (f32x4*)(x + (size_t)(m0 + r * mstride) * DM) + lane;
#pragma unroll
        for (int j = 0; j < 4; ++j) xo[64 * j] = (v[r][j] * rstd) * g[j]; }
}
template <int NR> __device__ __forceinline__ void prep_rows(const Params& P, int l, int m0, int mstride, int lane) {
    const bf16* proj = (const bf16*)(P.ws + WS_PROJ);
    unsigned wq[NR][3], wk[NR][2]; float sq[NR], sk[NR]; float x1[NR], x2[NR], cc[NR], ss[NR];
#pragma unroll
    for (int r = 0; r < NR; ++r) { const int row = m0 + r * mstride; const bf16* pr = proj + (size_t)row * NINP;
        const unsigned* s1 = (const unsigned*)(pr + COL_CQ); const unsigned* s2 = (const unsigned*)(pr + COL_CKV);
#pragma unroll
        for (int j = 0; j < 3; ++j) wq[r][j] = s1[lane + 64 * j];
#pragma unroll
        for (int j = 0; j < 2; ++j) wk[r][j] = s2[lane + 64 * j];
        x1[r] = bf1(pr[COL_KPE + (lane & 15)]); x2[r] = bf1(pr[COL_KPE + 16 + (lane & 15)]);
        cc[r] = ((const float*)(P.ws + WS_COS))[(size_t)row * 16 + (lane & 15)]; ss[r] = ((const float*)(P.ws + WS_SIN))[(size_t)row * 16 + (lane & 15)]; }
#pragma unroll
    for (int r = 0; r < NR; ++r) { float a = 0.f, c = 0.f;
#pragma unroll
        for (int j = 0; j < 3; ++j) { const float p = bflo(wq[r][j]), q = bfhi(wq[r][j]); a += p * p + q * q; }
#pragma unroll
        for (int j = 0; j < 2; ++j) { const float p = bflo(wk[r][j]), q = bfhi(wk[r][j]); c += p * p + q * q; }
        sq[r] = a; sk[r] = c; }
#pragma unroll
    for (int o2 = 1; o2 < 64; o2 <<= 1) {
#pragma unroll
        for (int r = 0; r < NR; ++r) { sq[r] += __shfl_xor(sq[r], o2); sk[r] += __shfl_xor(sk[r], o2); } }
    const float* gq = P.q_norm + l * 384; const float* gk = P.kv_norm + l * 256;
#pragma unroll
    for (int r = 0; r < NR; ++r) { const int row = m0 + r * mstride;
        const float rq = 1.0f / sqrtf(sq[r] * (1.f / 384.f) + EPS), rk = 1.0f / sqrtf(sk[r] * (1.f / 256.f) + EPS);
        unsigned* dq = (unsigned*)((bf16*)(P.ws + WS_CQN) + (size_t)row * 384); unsigned* dk = (unsigned*)((bf16*)(P.ws + WS_CKVN) + (size_t)row * 256);
#pragma unroll
        for (int j = 0; j < 3; ++j) { const int c = 2 * (lane + 64 * j); dq[lane + 64 * j] = pk2(bflo(wq[r][j]) * rq * gq[c], bfhi(wq[r][j]) * rq * gq[c + 1]); }
#pragma unroll
        for (int j = 0; j < 2; ++j) { const int c = 2 * (lane + 64 * j); dk[lane + 64 * j] = pk2(bflo(wk[r][j]) * rk * gk[c], bfhi(wk[r][j]) * rk * gk[c + 1]); }
        if (lane < 16) { bf16* kd = (bf16*)(P.ws + WS_KPE) + (size_t)row * 32;
            kd[lane] = (bf16)f2bf(x1[r] * cc[r] - x2[r] * ss[r]); kd[lane + 16] = (bf16)f2bf(x1[r] * ss[r] + x2[r] * cc[r]); } }
}
template <int NR> __device__ __forceinline__ void ssdnorm_rows(const Params& P, int l, int m0, int mstride, int lane) {
    v4u a[NR], b[NR]; float s[NR];
#pragma unroll
    for (int r = 0; r < NR; ++r) { const v4u* mr = (const v4u*)((const bf16*)(P.ws + WS_MIX) + (size_t)(m0 + r * mstride) * MIXW); a[r] = mr[lane]; b[r] = mr[lane + 64]; }
#pragma unroll
    for (int r = 0; r < NR; ++r) { const unsigned wa[4] = {a[r].x, a[r].y, a[r].z, a[r].w}, wb[4] = {b[r].x, b[r].y, b[r].z, b[r].w}; float t = 0.f;
#pragma unroll
        for (int j = 0; j < 4; ++j) { const float p = bflo(wa[j]), q = bfhi(wa[j]), u = bflo(wb[j]), v = bfhi(wb[j]); t += p * p + q * q + u * u + v * v; }
        s[r] = t; }
#pragma unroll
    for (int o2 = 1; o2 < 64; o2 <<= 1) {
#pragma unroll
        for (int r = 0; r < NR; ++r) s[r] += __shfl_xor(s[r], o2); }
    const float* g = P.ssd_norm + l * 1024;
    const f32x4 ga0 = *(const f32x4*)(g + 8 * lane), ga1 = *(const f32x4*)(g + 8 * lane + 4), gb0 = *(const f32x4*)(g + 512 + 8 * lane), gb1 = *(const f32x4*)(g + 512 + 8 * lane + 4);
#pragma unroll
    for (int r = 0; r < NR; ++r) { const float rstd = 1.0f / sqrtf(s[r] * (1.f / 1024.f) + EPS);
        v4u oa, ob;
        oa.x = pk2(bflo(a[r].x) * rstd * ga0[0], bfhi(a[r].x) * rstd * ga0[1]); oa.y = pk2(bflo(a[r].y) * rstd * ga0[2], bfhi(a[r].y) * rstd * ga0[3]);
        oa.z = pk2(bflo(a[r].z) * rstd * ga1[0], bfhi(a[r].z) * rstd * ga1[1]); oa.w = pk2(bflo(a[r].w) * rstd * ga1[2], bfhi(a[r].w) * rstd * ga1[3]);
        ob.x = pk2(bflo(b[r].x) * rstd * gb0[0], bfhi(b[r].x) * rstd * gb0[1]); ob.y = pk2(bflo(b[r].y) * rstd * gb0[2], bfhi(b[r].y) * rstd * gb0[3]);
        ob.z = pk2(bflo(b[r].z) * rstd * gb1[0], bfhi(b[r].z) * rstd * gb1[1]); ob.w = pk2(bflo(b[r].w) * rstd * gb1[2], bfhi(b[r].w) * rstd * gb1[3]);
        v4u* mo = (v4u*)((bf16*)(P.ws + WS_MIX) + (size_t)(m0 + r * mstride) * MIXW); mo[lane] = oa; mo[lane + 64] = ob; }
}
__device__ __forceinline__ void bc_prepass_generic(const Params& P, int l, int gtid, int ngt) {
    const bf16* proj = (const bf16*)(P.ws + WS_PROJ); bf16* bc = (bf16*)(P.ws + WS_BC);
    const float* cw = P.ssd_conv_w + (size_t)l * 4 * 1536 + 1024; const float* cbias = P.ssd_conv_b + (size_t)l * 1536 + 1024;
    const int c8 = (gtid & 63) * 8;
    f32x4 w0[4], w1[4];
#pragma unroll
    for (int k = 0; k < 4; ++k) { w0[k] = *(const f32x4*)(cw + k * 1536 + c8); w1[k] = *(const f32x4*)(cw + k * 1536 + c8 + 4); }
    const f32x4 b0 = *(const f32x4*)(cbias + c8), b1 = *(const f32x4*)(cbias + c8 + 4);
    for (int u = gtid; u < MROWS * 64; u += 4 * ngt) {
        v4u v[4][4]; int rows[4];
#pragma unroll
        for (int q = 0; q < 4; ++q) { const int row = (u + q * ngt) >> 6; rows[q] = row; const int sp = row & (SEQ - 1);
#pragma unroll
            for (int k = 0; k < 4; ++k) { const int rr = (sp - 3 + k >= 0) ? row - 3 + k : row; v[q][k] = *(const v4u*)(proj + (size_t)rr * NINP + COL_XBC + 1024 + c8); } }
#pragma unroll
        for (int q = 0; q < 4; ++q) { const int row = rows[q]; const int sp = row & (SEQ - 1);
            f32x4 a0 = b0, a1 = b1;
#pragma unroll
            for (int k = 0; k < 4; ++k) { const float m = (sp - 3 + k >= 0) ? 1.f : 0.f; const v4u t = v[q][k];
                a0 += (w0[k] * m) * (f32x4){bflo(t.x), bfhi(t.x), bflo(t.y), bfhi(t.y)}; a1 += (w1[k] * m) * (f32x4){bflo(t.z), bfhi(t.z), bflo(t.w), bfhi(t.w)}; }
            v4u o; o.x = pk2(pg8::fast_silu(a0[0]), pg8::fast_silu(a0[1])); o.y = pk2(pg8::fast_silu(a0[2]), pg8::fast_silu(a0[3]));
            o.z = pk2(pg8::fast_silu(a1[0]), pg8::fast_silu(a1[1])); o.w = pk2(pg8::fast_silu(a1[2]), pg8::fast_silu(a1[3]));
            if (row < MROWS) *(v4u*)(bc + (size_t)row * 512 + c8) = o; }
    }
}
__device__ __forceinline__ void bc_prepass(const Params& P, int l, int gtid, int ngt) {
    const int nseg = ngt >> 6; const int rps = (nseg > 0) ? MROWS / nseg : 0;
    if ((ngt & 63) != 0 || nseg * rps != MROWS || (rps & 3) != 0 || (SEQ % rps) != 0) { bc_prepass_generic(P, l, gtid, ngt); return; }
    const bf16* proj = (const bf16*)(P.ws + WS_PROJ); bf16* bc = (bf16*)(P.ws + WS_BC);
    const float* cw = P.ssd_conv_w + (size_t)l * 4 * 1536 + 1024; const float* cbias = P.ssd_conv_b + (size_t)l * 1536 + 1024;
    const int c8 = (gtid & 63) * 8; const int row0 = (gtid >> 6) * rps;
    f32x4 w0[4], w1[4];
#pragma unroll
    for (int k = 0; k < 4; ++k) { w0[k] = *(const f32x4*)(cw + k * 1536 + c8); w1[k] = *(const f32x4*)(cw + k * 1536 + c8 + 4); }
    const f32x4 b0 = *(const f32x4*)(cbias + c8), b1 = *(const f32x4*)(cbias + c8 + 4);
    const bf16* src = proj + (size_t)row0 * NINP + COL_XBC + 1024 + c8; bf16* dst = bc + (size_t)row0 * 512 + c8;
    const bool seqstart = (row0 & (SEQ - 1)) == 0;
    v4u h0 = (v4u){0u, 0u, 0u, 0u}, h1 = h0, h2 = h0;
    if (!seqstart) { h0 = *(const v4u*)(src - 3 * (long)NINP); h1 = *(const v4u*)(src - 2 * (long)NINP); h2 = *(const v4u*)(src - (long)NINP); }
#define BC_TAP(A0, A1, W0, W1, T) do { A0 += W0 * (f32x4){bflo(T.x), bfhi(T.x), bflo(T.y), bfhi(T.y)}; A1 += W1 * (f32x4){bflo(T.z), bfhi(T.z), bflo(T.w), bfhi(T.w)}; } while (0)
#define BC_OUT(R, X0, X1, X2, X3) do { f32x4 a0 = b0, a1 = b1; BC_TAP(a0, a1, w0[0], w1[0], X0); BC_TAP(a0, a1, w0[1], w1[1], X1); BC_TAP(a0, a1, w0[2], w1[2], X2); BC_TAP(a0, a1, w0[3], w1[3], X3); \
        v4u o; o.x = pk2(pg8::fast_silu(a0[0]), pg8::fast_silu(a0[1])); o.y = pk2(pg8::fast_silu(a0[2]), pg8::fast_silu(a0[3])); \
        o.z = pk2(pg8::fast_silu(a1[0]), pg8::fast_silu(a1[1])); o.w = pk2(pg8::fast_silu(a1[2]), pg8::fast_silu(a1[3])); *(v4u*)(dst + (size_t)(R) * 512) = o; } while (0)
    for (int r = 0; r < rps; r += 4) {
        const v4u c0 = *(const v4u*)(src + (size_t)(r + 0) * NINP), c1 = *(const v4u*)(src + (size_t)(r + 1) * NINP), c2 = *(const v4u*)(src + (size_t)(r + 2) * NINP), c3 = *(const v4u*)(src + (size_t)(r + 3) * NINP);
        BC_OUT(r + 0, h0, h1, h2, c0); BC_OUT(r + 1, h1, h2, c0, c1); BC_OUT(r + 2, h2, c0, c1, c2); BC_OUT(r + 3, c0, c1, c2, c3);
        h0 = c1; h1 = c2; h2 = c3;
    }
#undef BC_TAP
#undef BC_OUT
}
constexpr int BPI = 136;
constexpr int SL_X = 0, SL_X2 = 128  , SL_B = 34816, SL_C = 69632, SL_H = 104448, SL_DT = 121856, SL_CUM = SL_DT + 512, SL_W = SL_CUM + 512, SL_EC = SL_W + 512, SL_F = SL_EC + 512, SL_CR = SL_F + 512, SL_CW = SL_CR + 16  ;
__device__ __forceinline__ bf16x8 tr_frag(const unsigned char* base, int pitch_bytes) {
    const s16x4 lo = __builtin_bit_cast(s16x4, __builtin_amdgcn_ds_read_tr16_b64_v4i16((LAS s16x4*)(const LAS unsigned char*)base));
    const s16x4 hi4 = __builtin_bit_cast(s16x4, __builtin_amdgcn_ds_read_tr16_b64_v4i16((LAS s16x4*)((const LAS unsigned char*)base + 8 * pitch_bytes)));
    return (bf16x8){lo[0], lo[1], lo[2], lo[3], hi4[0], hi4[1], hi4[2], hi4[3]};
}
__device__ __forceinline__ void ssd_item(const Params& P, int l, int b, int h, unsigned char* lds, int tid) {
    const int lane = tid & 63, wid = tid >> 6, r32 = lane & 31, hi = lane >> 5;
    const int pb = wid & 1, lj = ((wid >> 1) & 1) ? ((wid >> 2) ? 2 : 1) : ((wid >> 2) ? 3 : 0), pb2 = wid >> 2, nb = wid & 3;
    const int trg = lane >> 4, tri = lane & 15;
    const int tr_row = 4 * (trg >> 1) + (tri >> 2), tr_col = 16 * (trg & 1) + 4 * (tri & 3);
    const int g = h >> 3;
    const float LOG2E = 1.4426950408889634f;
    const float aneg2 = -__expf(P.ssd_a_log[l * 16 + h]) * LOG2E; const float dtb = P.ssd_dt_bias[l * 16 + h]; const float dsk = P.ssd_d[l * 16 + h];
    const bf16* proj = (const bf16*)(P.ws + WS_PROJ); bf16* mix = (bf16*)(P.ws + WS_MIX);
    float* dtA = (float*)(lds + SL_DT); float* cumA = (float*)(lds + SL_CUM); float* wA = (float*)(lds + SL_W); float* ecA = (float*)(lds + SL_EC); float* fA = (float*)(lds + SL_F); float* crA = (float*)(lds + SL_CR);
    const int cp = tid & 31, seg = tid >> 5, ch = cp * 2, t0 = 8 * seg;
    const int cc = h * 64 + ch;
    __syncthreads();
    if (tid < 32) { const float* cw = P.ssd_conv_w + (size_t)l * 4 * 1536; const float* cbias = P.ssd_conv_b + (size_t)l * 1536; float* d = (float*)(lds + SL_CW) + tid * 12;
#pragma unroll
      for (int k = 0; k < 4; ++k) { d[k] = cw[k * 1536 + cc]; d[4 + k] = cw[k * 1536 + cc + 1]; }
      d[8] = cbias[cc]; d[9] = cbias[cc + 1]; d[10] = 0.f; d[11] = 0.f; }
    const float* cwl = (const float*)(lds + SL_CW) + cp * 12;
    unsigned char* dimg = lds + SL_X + ch * 2 + t0 * BPI * 2;
    const float* wAt = wA + t0;
    constexpr int dpitch = BPI * 2;
    unsigned raw[11];
    v4u bcr[8];
    unsigned dtr0 = 0, dtr1 = 0;
    const bf16* pcol = proj + (size_t)b * SEQ * NINP + COL_XBC + cc;
    const bf16* bcp = (const bf16*)(P.ws + WS_BC) + ((size_t)b * SEQ + (tid >> 5)) * 512 + g * 128 + ((tid & 31) < 16 ? (tid & 31) * 8 : 256 + ((tid & 31) - 16) * 8);
    unsigned char* bcdst = lds + ((tid & 31) < 16 ? SL_B + (tid & 31) * 16 : SL_C + ((tid & 31) - 16) * 16) + (tid >> 5) * BPI * 2;
#define SSD_LOADRAW(c_) do { \
        { const bf16* pp_ = pcol + ((long)(c_) * 128 + t0 - 3) * NINP; \
        _Pragma("unroll") for (int i = 0; i < 11; ++i) { raw[i] = *(const unsigned*)pp_; pp_ += NINP; } \
        if ((c_) == 0 && seg == 0) { raw[0] = 0u; raw[1] = 0u; raw[2] = 0u; } \
        _Pragma("unroll") for (int j = 0; j < 8; ++j) bcr[j] = *(const v4u*)(bcp + ((size_t)(c_) * 128 + 16 * j) * 512); } } while (0)
#define SSD_LOADDT(c_) do { \
        if (wid == 0) { const bf16* dp = proj + ((size_t)b * SEQ + (size_t)(c_) * 128 + 2 * lane) * NINP + COL_DT + h; dtr0 = dp[0]; dtr1 = dp[NINP]; } } while (0)
    SSD_LOADDT(0);
    SSD_LOADRAW(0);
    f32x16 Hacc;
#pragma unroll
    for (int r = 0; r < 16; ++r) Hacc[r] = 0.f;
    __syncthreads();
    for (int i = tid; i < 64 * BPI / 2; i += NTHR) ((unsigned*)(lds + SL_H))[i] = 0u;
    for (int c = 0; c < SEQ / 128; ++c) {
        const size_t row0 = (size_t)b * SEQ + (size_t)c * 128;
        if (wid == 0) {
            const float v0 = bf1((bf16)dtr0) + dtb, v1 = bf1((bf16)dtr1) + dtb;
            const float dt0 = v0 > 20.f ? v0 : log1pf(__expf(v0)), dt1 = v1 > 20.f ? v1 : log1pf(__expf(v1));
            const float da0 = dt0 * aneg2, da1 = dt1 * aneg2;
            const float s1 = da0 + da1; float x = s1;
#pragma unroll
            for (int o = 1; o < 64; o <<= 1) { const float t = __shfl_up(x, o); if (lane >= o) x += t; }
            const float c0 = x - s1 + da0, c1 = x; const float tot = __shfl(x, 63);
            dtA[2 * lane] = dt0; dtA[2 * lane + 1] = dt1; cumA[2 * lane] = c0; cumA[2 * lane + 1] = c1;
            wA[2 * lane] = dt0 * __builtin_amdgcn_exp2f(tot - c0); wA[2 * lane + 1] = dt1 * __builtin_amdgcn_exp2f(tot - c1);
            ecA[2 * lane] = __builtin_amdgcn_exp2f(c0); ecA[2 * lane + 1] = __builtin_amdgcn_exp2f(c1);
            { const float cend = __shfl(x, lane | 15);
              fA[2 * lane] = dt0 * __builtin_amdgcn_exp2f(cend - c0); fA[2 * lane + 1] = dt1 * __builtin_amdgcn_exp2f(cend - c1);
              if ((lane & 15) == 0) crA[lane >> 4] = cend; }
        }
        LBAR();
        {
            const f32x4 cwa = *(const f32x4*)cwl, cwb = *(const f32x4*)(cwl + 4), cwc = *(const f32x4*)(cwl + 8);
            typedef float f2 __attribute__((ext_vector_type(2)));
            const f2 wk[4] = {(f2){cwa[0], cwb[0]}, (f2){cwa[1], cwb[1]}, (f2){cwa[2], cwb[2]}, (f2){cwa[3], cwb[3]}}; const f2 bias2 = (f2){cwc[0], cwc[1]};
            f2 xr[11];
#pragma unroll
            for (int i = 0; i < 11; ++i) xr[i] = (f2){bflo(raw[i]), bfhi(raw[i])};
#pragma unroll
            for (int i = 0; i < 8; ++i) {
                f2 a = bias2;
#pragma unroll
                for (int k = 0; k < 4; ++k) a += wk[k] * xr[i + k];
                const f2 e = a * -1.4426950408889634f;
                f2 den; den.x = __builtin_amdgcn_exp2f(e.x); den.y = __builtin_amdgcn_exp2f(e.y); den += 1.0f;
                f2 rc; rc.x = __builtin_amdgcn_rcpf(den.x); rc.y = __builtin_amdgcn_rcpf(den.y);
                a = a * rc;
                *(unsigned*)(dimg + i * dpitch) = pk2(a.x, a.y);
                const f2 aw = a * wAt[i]; *(unsigned*)(dimg + SL_X2 + i * dpitch) = pk2(aw.x, aw.y);
            }
#pragma unroll
            for (int j = 0; j < 8; ++j) *(v4u*)(bcdst + 16 * j * BPI * 2) = bcr[j];
        }
        asm volatile("" ::: "memory");
        if (c + 1 < SEQ / 128) { SSD_LOADDT(c + 1); }
        const int lrow = 32 * lj + r32;
        v2u zr[4];
#pragma unroll
        for (int r4 = 0; r4 < 4; ++r4) zr[r4] = *(const v2u*)(proj + (row0 + lrow) * NINP + COL_Z + h * 64 + 32 * pb + 8 * r4 + 4 * hi);
        LBAR();
        const float cl = cumA[lrow];
        const unsigned char* cfp = lds + SL_C + (lrow * BPI + 8 * hi) * 2;
#define CF(ks) (*(const bf16x8*)(cfp + 32 * (ks)))
        f32x16 y;
        { f32x16 T;
#pragma unroll
          for (int r = 0; r < 16; ++r) T[r] = 0.f;
#pragma unroll
          for (int ks = 0; ks < 8; ++ks) { const bf16x8 hf = *(const bf16x8*)(lds + SL_H + ((32 * pb + r32) * BPI + 16 * ks + 8 * hi) * 2); T = __builtin_amdgcn_mfma_f32_32x32x16_bf16(hf, CF(ks), T, 0, 0, 0); }
          const float ecl = ecA[lrow];
#pragma unroll
          for (int r = 0; r < 16; ++r) y[r] = ecl * T[r]; }
#define SSD_SCORES(si_) \
            f32x16 s; \
            _Pragma("unroll") for (int r = 0; r < 16; ++r) s[r] = 0.f; \
            _Pragma("unroll") for (int ks = 0; ks < 8; ++ks) { const bf16x8 bfr = *(const bf16x8*)(lds + SL_B + ((32 * (si_) + r32) * BPI + 16 * ks + 8 * hi) * 2); s = __builtin_amdgcn_mfma_f32_32x32x16_bf16(bfr, CF(ks), s, 0, 0, 0); }
#define SSD_APPLY(si_) do { \
            const v4u pf0 = (v4u){pk2(s[0], s[1]), pk2(s[2], s[3]), pk2(s[4], s[5]), pk2(s[6], s[7])}; \
            const v4u pf1 = (v4u){pk2(s[8], s[9]), pk2(s[10], s[11]), pk2(s[12], s[13]), pk2(s[14], s[15])}; \
            { const bf16x8 xa = tr_frag(lds + SL_X + ((32 * (si_) + tr_row) * BPI + 32 * pb + tr_col) * 2, BPI * 2); \
              y = __builtin_amdgcn_mfma_f32_32x32x16_bf16(xa, __builtin_bit_cast(bf16x8, pf0), y, 0, 0, 0); } \
            { const bf16x8 xa = tr_frag(lds + SL_X + ((32 * (si_) + 16 + tr_row) * BPI + 32 * pb + tr_col) * 2, BPI * 2); \
              y = __builtin_amdgcn_mfma_f32_32x32x16_bf16(xa, __builtin_bit_cast(bf16x8, pf1), y, 0, 0, 0); } } while (0)
        for (int si = 0; si < lj; ++si) {
            SSD_SCORES(si)
            const float el = __builtin_amdgcn_exp2f(cl - crA[si]);
#pragma unroll
            for (int r4 = 0; r4 < 4; ++r4) { const f32x4 f4 = *(const f32x4*)(fA + 32 * si + 8 * r4 + 4 * hi);
#pragma unroll
                for (int j = 0; j < 4; ++j) { const int r = 4 * r4 + j; s[r] = s[r] * (f4[j] * el); } }
            SSD_APPLY(si);
            asm volatile("" ::: "memory");
        }
        {
            SSD_SCORES(lj)
#pragma unroll
            for (int r = 0; r < 16; ++r) { const int cr = (r & 3) + 8 * (r >> 2) + 4 * hi; const int srow = 32 * lj + cr;
                const bool ok = (cr <= r32);
                const float arg = ok ? (cl - cumA[srow]) : 0.f;
                float gv = s[r] * __builtin_amdgcn_exp2f(arg) * dtA[srow];
                gv = ok ? gv : 0.f;
                if (cr == r32) gv += dsk;
                s[r] = gv; }
            SSD_APPLY(lj);
        }
#undef SSD_SCORES
#undef SSD_APPLY
        { const float dec = ecA[127];
#pragma unroll
          for (int r = 0; r < 16; ++r) Hacc[r] *= dec;
#pragma unroll
          for (int ks = 0; ks < 8; ++ks) {
              const bf16x8 xa = tr_frag(lds + SL_X2 + ((16 * ks + tr_row) * BPI + 32 * pb2 + tr_col) * 2, BPI * 2);
              const bf16x8 bb = tr_frag(lds + SL_B + ((16 * ks + tr_row) * BPI + 32 * nb + tr_col) * 2, BPI * 2);
              Hacc = __builtin_amdgcn_mfma_f32_32x32x16_bf16(xa, bb, Hacc, 0, 0, 0); } }
        LBAR();
        if (c + 1 < SEQ / 128) SSD_LOADRAW(c + 1);
#pragma unroll
        for (int r = 0; r < 16; ++r) { const int cr = (r & 3) + 8 * (r >> 2) + 4 * hi; *(bf16*)(lds + SL_H + ((32 * pb2 + cr) * BPI + 32 * nb + r32) * 2) = (bf16)f2bf(Hacc[r]); }
#pragma unroll
        for (int r4 = 0; r4 < 4; ++r4) {
            const int p0 = 32 * pb + 8 * r4 + 4 * hi;
            const v2u z = zr[r4];
            typedef float f2 __attribute__((ext_vector_type(2)));
            const f2 za = (f2){bflo(z.x), bfhi(z.x)}, zb = (f2){bflo(z.y), bfhi(z.y)};
            const f2 ea = za * -1.4426950408889634f, eb = zb * -1.4426950408889634f;
            f2 da, db; da.x = __builtin_amdgcn_exp2f(ea.x); da.y = __builtin_amdgcn_exp2f(ea.y); db.x = __builtin_amdgcn_exp2f(eb.x); db.y = __builtin_amdgcn_exp2f(eb.y); da += 1.0f; db += 1.0f;
            f2 ra, rb; ra.x = __builtin_amdgcn_rcpf(da.x); ra.y = __builtin_amdgcn_rcpf(da.y); rb.x = __builtin_amdgcn_rcpf(db.x); rb.y = __builtin_amdgcn_rcpf(db.y);
            const f2 oa = (f2){y[4 * r4 + 0], y[4 * r4 + 1]} * (za * ra), ob = (f2){y[4 * r4 + 2], y[4 * r4 + 3]} * (zb * rb);
            v2u o; o.x = pk2(oa.x, oa.y); o.y = pk2(ob.x, ob.y);
            *(v2u*)(mix + (row0 + lrow) * MIXW + h * 64 + p0) = o;
        }
    }
#undef SSD_LOADRAW
#undef SSD_LOADDT
    __syncthreads();
}
constexpr int PLP = 136;
template <int GI> __device__ __forceinline__ void pool_item_t(const Params& P, int l, int tile, unsigned char* lds, int tid) {
    constexpr int gi = GI, WSZ = 2 << GI;
    const int lane = tid & 63, wid = tid >> 6, r32 = lane & 31, hi = lane >> 5;
    const bf16* proj = (const bf16*)(P.ws + WS_PROJ); bf16* mix = (bf16*)(P.ws + WS_MIX);
    const bf16* wt = (const bf16*)(P.ws + WS_W + (size_t)l * W_LAYER + WO_POOL) + (size_t)gi * 128 * 128;
    unsigned char* WTi = lds; unsigned char* PLi = lds + 128 * PLP * 2;
    const int cp = lane, tbase = wid * 16;
    const int tq = wid >> 1, dh = wid & 1;
    unsigned rw[WSZ + 15];
#define POOL_LOADW(sub_) do { const int r0_ = tile * 256 + (sub_) * 128; const int s0_ = r0_ & (SEQ - 1); \
        const bf16* up_ = proj + (size_t)r0_ * NINP + COL_U + gi * 128 + cp * 2; \
        _Pragma("unroll") for (int i = 0; i < WSZ + 15; ++i) { const int t = tbase - (WSZ - 1) + i; const unsigned v = *(const unsigned*)(up_ + (long)((s0_ + t >= 0) ? t : 0) * NINP); rw[i] = (s0_ + t >= 0) ? v : 0u; } } while (0)
    POOL_LOADW(0);
    f32x4 scv[2][4];
#pragma unroll
    for (int dbi = 0; dbi < 2; ++dbi)
#pragma unroll
        for (int r4 = 0; r4 < 4; ++r4) scv[dbi][r4] = *(const f32x4*)(P.pool_scale + l * 512 + gi * 128 + 32 * (2 * dh + dbi) + 8 * r4 + 4 * hi);
    LBAR();
    for (int i = tid; i < 2048; i += NTHR) { const int d = i >> 4, chk = i & 15; *(v4u*)(WTi + (d * PLP + chk * 8) * 2) = *(const v4u*)(wt + d * 128 + chk * 8); }
    for (int sub = 0; sub < 2; ++sub) {
        const int r0 = tile * 256 + sub * 128; const int s0 = r0 & (SEQ - 1);
        LBAR();
        { float sa = 0.f, sb = 0.f;
#pragma unroll
          for (int i = 0; i < WSZ - 1; ++i) { sa += bflo(rw[i]); sb += bfhi(rw[i]); }
#pragma unroll
          for (int j = 0; j < 16; ++j) { const int t = tbase + j; const float a = bflo(rw[WSZ - 1 + j]), bq = bfhi(rw[WSZ - 1 + j]);
              sa += a; sb += bq; const int sp = s0 + t; const float inv = __builtin_amdgcn_rcpf((float)((sp + 1) < WSZ ? (sp + 1) : WSZ));
              *(unsigned*)(PLi + (t * PLP + cp * 2) * 2) = pk2(sa * inv - a, sb * inv - bq);
              sa -= bflo(rw[j]); sb -= bfhi(rw[j]); } }
        if (sub == 0) POOL_LOADW(1);
        LBAR();
        bf16x8 pfr[8];
#pragma unroll
        for (int ks = 0; ks < 8; ++ks) pfr[ks] = *(const bf16x8*)(PLi + ((32 * tq + r32) * PLP + 16 * ks + 8 * hi) * 2);
#pragma unroll
        for (int dbi = 0; dbi < 2; ++dbi) { const int db = 2 * dh + dbi;
            f32x16 acc;
#pragma unroll
            for (int r = 0; r < 16; ++r) acc[r] = 0.f;
#pragma unroll
            for (int ks = 0; ks < 8; ++ks) { const bf16x8 wf = *(const bf16x8*)(WTi + ((32 * db + r32) * PLP + 16 * ks + 8 * hi) * 2); acc = __builtin_amdgcn_mfma_f32_32x32x16_bf16(wf, pfr[ks], acc, 0, 0, 0); }
#pragma unroll
            for (int r4 = 0; r4 < 4; ++r4) { const int d0 = 32 * db + 8 * r4 + 4 * hi; const f32x4 sc = scv[dbi][r4];
                v2u o; o.x = pk2(acc[4 * r4 + 0] * sc[0], acc[4 * r4 + 1] * sc[1]); o.y = pk2(acc[4 * r4 + 2] * sc[2], acc[4 * r4 + 3] * sc[3]);
                *(v2u*)(mix + (size_t)(r0 + 32 * tq + r32) * MIXW + 1024 + gi * 128 + d0) = o; } }
    }
#undef POOL_LOADW
}
__device__ __forceinline__ void pool_item(const Params& P, int l, int tile, int gi, unsigned char* lds, int tid) {
    if (gi == 0) pool_item_t<0>(P, l, tile, lds, tid); else if (gi == 1) pool_item_t<1>(P, l, tile, lds, tid); else if (gi == 2) pool_item_t<2>(P, l, tile, lds, tid); else pool_item_t<3>(P, l, tile, lds, tid);
}
constexpr int KP = 104, VP = 72;
constexpr int ATT_BUF = 64 * KP * 2 + 64 * VP * 2;
__device__ __forceinline__ void attn_unit(const Params& P, int b, int h, int qb, unsigned char* lds, int tid) {
    const int lane = tid & 63, wid = tid >> 6, r32 = lane & 31, hi = lane >> 5;
    const bf16* QB = (const bf16*)(P.ws + WS_QB); const bf16* KVB = (const bf16*)(P.ws + WS_KVB); const bf16* KPE = (const bf16*)(P.ws + WS_KPE); bf16* mix = (bf16*)(P.ws + WS_MIX);
    const size_t rowb = (size_t)b * SEQ; const int q0 = qb * 256;
    const int rs = (wid < 4) ? wid : 11 - wid;
    bf16x8 qr[6];
    { const bf16* qp = QB + (rowb + q0 + rs * 32 + r32) * 768 + h * 96 + hi * 8;
#pragma unroll
      for (int d0 = 0; d0 < 6; ++d0) qr[d0] = *(const bf16x8*)(qp + d0 * 16); }
    f32x16 o0, o1;
#pragma unroll
    for (int r = 0; r < 16; ++r) { o0[r] = 0.f; o1[r] = 0.f; }
    float mrun = -1e30f, lrun = 0.f;
    const int NT = (q0 + 256) / 64;
    const int krow = tid >> 3, kch = tid & 7;
    const int prow = (tid & 255) >> 2, pch = tid & 3;
    v4u kreg, preg = (v4u){0u, 0u, 0u, 0u}, vreg;
    auto gload = [&](int t) {
        const size_t r = rowb + (size_t)t * 64;
        kreg = *(const v4u*)(KVB + (r + krow) * 1024 + h * 128 + kch * 8);
        vreg = *(const v4u*)(KVB + (r + krow) * 1024 + h * 128 + 64 + kch * 8);
        if (tid < 256) preg = *(const v4u*)(KPE + (r + prow) * 32 + pch * 8);
    };
    auto lstore = [&](int buf) {
        unsigned char* kb = lds + buf * ATT_BUF; unsigned char* vb = kb + 64 * KP * 2;
        *(v4u*)(kb + (krow * KP + kch * 8) * 2) = kreg;
        *(v4u*)(vb + (krow * VP + kch * 8) * 2) = vreg;
        if (tid < 256) *(v4u*)(kb + (prow * KP + 64 + pch * 8) * 2) = preg;
    };
    LBAR();
    gload(0); lstore(0);
    LBAR();
    const int qrel = rs * 32 + r32;
    const int trg = lane >> 4, tri = lane & 15;
    const int tr_row = 4 * (trg >> 1) + (tri >> 2), tr_col = 16 * (trg & 1) + 4 * (tri & 3);
    for (int t = 0; t < NT; ++t) {
        const int buf = t & 1;
        if (t + 1 < NT) gload(t + 1);
        const unsigned char* kb = lds + buf * ATT_BUF; const unsigned char* vb = kb + 64 * KP * 2;
        if (!(t - (NT - 4) >= 0 && 64 * (t - (NT - 4)) > 32 * __builtin_amdgcn_readfirstlane(rs) + 31)) {
        f32x16 p0, p1;
#pragma unroll
        for (int r = 0; r < 16; ++r) { p0[r] = 0.f; p1[r] = 0.f; }
#pragma unroll
        for (int d0 = 0; d0 < 6; ++d0) {
            const bf16x8 k0 = *(const bf16x8*)(kb + (r32 * KP + d0 * 16 + hi * 8) * 2);
            const bf16x8 k1 = *(const bf16x8*)(kb + ((32 + r32) * KP + d0 * 16 + hi * 8) * 2);
            p0 = __builtin_amdgcn_mfma_f32_32x32x16_bf16(k0, qr[d0], p0, 0, 0, 0);
            p1 = __builtin_amdgcn_mfma_f32_32x32x16_bf16(k1, qr[d0], p1, 0, 0, 0);
        }
        const int jb = t - (NT - 4);
        if (jb >= 0) {
#pragma unroll
            for (int r = 0; r < 16; ++r) { const int kv = 64 * jb + (r & 3) + 8 * (r >> 2) + 4 * hi; if (kv > qrel) p0[r] = -1e30f; if (kv + 32 > qrel) p1[r] = -1e30f; }
        }
        float mx = p0[0];
#pragma unroll
        for (int r = 1; r < 16; ++r) mx = fmaxf(mx, p0[r]);
#pragma unroll
        for (int r = 0; r < 16; ++r) mx = fmaxf(mx, p1[r]);
        mx = fmaxf(mx, __shfl_xor(mx, 32));
        const float mnew = fmaxf(mrun, mx);
        const float alpha = __builtin_amdgcn_exp2f(mrun - mnew);
        mrun = mnew;
        float ls = 0.f;
#pragma unroll
        for (int r = 0; r < 16; ++r) { p0[r] = __builtin_amdgcn_exp2f(p0[r] - mnew); p1[r] = __builtin_amdgcn_exp2f(p1[r] - mnew); ls += p0[r] + p1[r]; }
        lrun = lrun * alpha + ls;
#pragma unroll
        for (int r = 0; r < 16; ++r) { o0[r] *= alpha; o1[r] *= alpha; }
        v4u pf[2][2];
#pragma unroll
        for (int s = 0; s < 2; ++s) {
            pf[0][s] = (v4u){pk2(p0[8 * s + 0], p0[8 * s + 1]), pk2(p0[8 * s + 2], p0[8 * s + 3]), pk2(p0[8 * s + 4], p0[8 * s + 5]), pk2(p0[8 * s + 6], p0[8 * s + 7])};
            pf[1][s] = (v4u){pk2(p1[8 * s + 0], p1[8 * s + 1]), pk2(p1[8 * s + 2], p1[8 * s + 3]), pk2(p1[8 * s + 4], p1[8 * s + 5]), pk2(p1[8 * s + 6], p1[8 * s + 7])};
        }
#pragma unroll
        for (int blk = 0; blk < 2; ++blk)
#pragma unroll
            for (int s = 0; s < 2; ++s) {
                const bf16x8 pfrag = __builtin_bit_cast(bf16x8, pf[blk][s]);
#pragma unroll
                for (int db = 0; db < 2; ++db) {
                    const LAS unsigned char* vp = (const LAS unsigned char*)vb + ((32 * blk + 16 * s + tr_row) * VP + 32 * db + tr_col) * 2;
                    const s16x4 lo = __builtin_bit_cast(s16x4, __builtin_amdgcn_ds_read_tr16_b64_v4i16((LAS s16x4*)vp));
                    const s16x4 hi4 = __builtin_bit_cast(s16x4, __builtin_amdgcn_ds_read_tr16_b64_v4i16((LAS s16x4*)(vp + 8 * VP * 2)));
                    const bf16x8 vf = (bf16x8){lo[0], lo[1], lo[2], lo[3], hi4[0], hi4[1], hi4[2], hi4[3]};
                    if (db == 0) o0 = __builtin_amdgcn_mfma_f32_32x32x16_bf16(vf, pfrag, o0, 0, 0, 0);
                    else o1 = __builtin_amdgcn_mfma_f32_32x32x16_bf16(vf, pfrag, o1, 0, 0, 0);
                }
            }
        }
        if (t + 1 < NT) lstore(buf ^ 1);
        LBAR();
    }
    lrun += __shfl_xor(lrun, 32);
    const float rl = 1.0f / lrun;
    bf16* op = mix + (rowb + q0 + rs * 32 + r32) * MIXW + 1536 + h * 64;
#pragma unroll
    for (int r4 = 0; r4 < 4; ++r4) {
        const int d = 8 * r4 + 4 * hi;
        v2u w0, w1;
        w0.x = pk2(o0[4 * r4 + 0] * rl, o0[4 * r4 + 1] * rl); w0.y = pk2(o0[4 * r4 + 2] * rl, o0[4 * r4 + 3] * rl);
        w1.x = pk2(o1[4 * r4 + 0] * rl, o1[4 * r4 + 1] * rl); w1.y = pk2(o1[4 * r4 + 2] * rl, o1[4 * r4 + 3] * rl);
        *(v2u*)(op + d) = w0; *(v2u*)(op + 32 + d) = w1;
    }
}
__device__ __forceinline__ void ffn_fixup(const Params& P, int l, int gtid, int ngt) {
    const float* RAW = (const float*)(P.ws + WS_RAW); bf16* ACT = (bf16*)(P.ws + WS_ACT);
    const float* cw = P.ffn_conv_w + (size_t)l * 3 * 5632; const float* cb = P.ffn_conv_b + (size_t)l * 5632;
    const int total = (MROWS / 64) * 2 * DFF;
    for (int idx = gtid; idx < total; idx += ngt) {
        const int gc = idx % DFF; const int ri = idx / DFF; const int i = ri & 1, blk = ri >> 1;
        const int pn = gc >> 7, rc = gc & 127; const int cg_ = pn * 256 + rc, cv_ = cg_ + 128;
        const bool first = (blk & 63) == 0;
        const float* r_cur = RAW + ((size_t)blk * 4 + i) * 5632;
        const float* r_m1 = (i == 1) ? RAW + ((size_t)blk * 4 + 0) * 5632 : RAW + ((size_t)(blk - 1) * 4 + 3) * 5632;
        const float* r_m2 = (i == 1) ? RAW + ((size_t)(blk - 1) * 4 + 3) * 5632 : RAW + ((size_t)(blk - 1) * 4 + 2) * 5632;
        const bool z1 = first && (i == 0), z2 = first;
        const float g0 = r_cur[cg_], v0 = r_cur[cv_];
        const float g1 = z1 ? 0.f : r_m1[cg_], v1 = z1 ? 0.f : r_m1[cv_];
        const float g2 = z2 ? 0.f : r_m2[cg_], v2 = z2 ? 0.f : r_m2[cv_];
        const float gg = cb[gc] + cw[gc] * g2 + cw[5632 + gc] * g1 + cw[2 * 5632 + gc] * g0;
        const float vv = cb[DFF + gc] + cw[DFF + gc] * v2 + cw[5632 + DFF + gc] * v1 + cw[2 * 5632 + DFF + gc] * v0;
        ACT[(size_t)(blk * 64 + i) * DFF + gc] = (bf16)f2bf(silu_f(gg) * vv);
    }
}

#define XB_TMO      128
#define XB_XCNT(j)  (256  + 64 * (j))
#define XB_XSUB(j)  (1280 + 64 * (j))
#define XB_XGEN(j)  (2304 + 64 * (j))
#define XB_TOP      3328
#define XB_TOPGEN   3392
#define XCD_BAR_WORDS 3456
#define XB_SPIN_CAP (1u << 18)

__device__ __forceinline__ unsigned xb_ld(unsigned* p)              { return __hip_atomic_load(p, __ATOMIC_RELAXED, __HIP_MEMORY_SCOPE_AGENT); }
__device__ __forceinline__ unsigned xb_add(unsigned* p, unsigned v) { return __hip_atomic_fetch_add(p, v, __ATOMIC_RELAXED, __HIP_MEMORY_SCOPE_AGENT); }
__device__ __forceinline__ unsigned xb_xcc_id() { return (unsigned)__builtin_amdgcn_s_getreg((3 << 11) | 20) & 0xFu; }
#define XB_SPIN(cond, bar) do { unsigned _sp = 0; while (cond) { __builtin_amdgcn_s_sleep(1); \
    if ((++_sp & 255u) == 0u) { if (xb_ld(&(bar)[XB_TMO])) break; if (_sp > XB_SPIN_CAP) { atomicAdd(&(bar)[XB_TMO], 1u); break; } } } } while (0)

struct XcdBarrier {
    unsigned* bar; unsigned x; bool t0;
    volatile LAS unsigned* st;
};

__device__ __forceinline__ XcdBarrier xcd_barrier_post(unsigned* bar, volatile LAS unsigned* st, bool t0) {
    XcdBarrier b; b.bar = bar; b.x = xb_xcc_id(); b.st = st; b.t0 = t0;
    if (t0) (void)xb_add(&bar[XB_XCNT(b.x)], 1u);
    return b;
}
__device__ __forceinline__ void xcd_barrier_complete(unsigned* bar, unsigned x, unsigned& nloc, unsigned& nx) {
    const unsigned G = gridDim.x * gridDim.y * gridDim.z;
    unsigned sum, cnt, mine, sp = 0u;
    for (;;) {
        sum = 0u; cnt = 0u; mine = 0u;
#pragma unroll
        for (unsigned j = 0; j < 16; ++j) { const unsigned c = xb_ld(&bar[XB_XCNT(j)]); sum += c; cnt += (c > 0u) ? 1u : 0u; mine = (j == x) ? c : mine; }
        if (sum == G) break;
        __builtin_amdgcn_s_sleep(1);
        if ((++sp & 255u) == 0u) { if (xb_ld(&bar[XB_TMO])) break; if (sp > XB_SPIN_CAP) { atomicAdd(&bar[XB_TMO], 1u); break; } }
    }
    nloc = mine > 0u ? mine : 1u; nx = cnt > 0u ? cnt : 1u;
}

__device__ __forceinline__ void xcd_barrier(const XcdBarrier& b) {
    asm volatile("s_waitcnt vmcnt(0)" ::: "memory");
    __syncthreads();
    if (b.t0) {
        unsigned* bar = b.bar;
        __builtin_amdgcn_s_waitcnt(0);
        unsigned nloc = b.st[0], nx = b.st[1];
        if (nloc == 0u) { xcd_barrier_complete(bar, b.x, nloc, nx); b.st[0] = nloc; b.st[1] = nx; }
        const unsigned old = xb_add(&bar[XB_XSUB(b.x)], 1u);
        const unsigned gen = old / nloc;
        if (old + 1u == (gen + 1u) * nloc) {
            __builtin_amdgcn_fence(__ATOMIC_RELEASE, "agent");
            asm volatile("s_waitcnt vmcnt(0)" ::: "memory");
            const unsigned og = xb_add(&bar[XB_TOP], 1u);
            const unsigned tg = og / nx;
            if (og + 1u == (tg + 1u) * nx) xb_add(&bar[XB_TOPGEN], 1u);
            else XB_SPIN(xb_ld(&bar[XB_TOPGEN]) == tg, bar);
            __builtin_amdgcn_fence(__ATOMIC_ACQUIRE, "agent");
            xb_add(&bar[XB_XGEN(b.x)], 1u);
            asm volatile("s_waitcnt vmcnt(0)" ::: "memory");
        } else {
            XB_SPIN(xb_ld(&bar[XB_XGEN(b.x)]) == gen, bar);
            __builtin_amdgcn_fence(__ATOMIC_ACQUIRE, "agent");
            asm volatile("s_waitcnt vmcnt(0)" ::: "memory");
        }
    }
    __syncthreads();
}

__device__ __forceinline__ unsigned fresh_lane_id() { unsigned z = 0u; asm volatile("" : "+v"(z)); return __builtin_amdgcn_mbcnt_hi(~0u, __builtin_amdgcn_mbcnt_lo(~0u, z)); }
__global__ void __launch_bounds__(NTHR, 2) fwd_kernel(Params P) {
    extern __shared__ __attribute__((aligned(16))) unsigned char lds[];
    cg::grid_group grid = cg::this_grid();
    const int G = gridDim.x, bid = blockIdx.x;
    const int vbid = ((G & 7) == 0) ? ((bid & 7) * (G >> 3) + (bid >> 3)) : bid;
    const int wave_s = __builtin_amdgcn_readfirstlane((int)(threadIdx.x >> 6));
#define MYTID() (wave_s * 64 + (int)fresh_lane_id())
    PG8_LAS unsigned char* lds3 = (PG8_LAS unsigned char*)lds;
    volatile LAS unsigned* xst = (volatile LAS unsigned*)((LAS unsigned char*)lds + MISC_OFF);
    { const int t0_ = MYTID(); if (t0_ < 2) xst[t0_] = 0u;
      unsigned* barw = (unsigned*)(P.ws + WS_CTL); if (blockIdx.x == 0) for (int i = t0_; i < XCD_BAR_WORDS; i += NTHR) barw[i] = 0u; }
#ifndef PHM
#define PHM 0xFFFF
#endif
#ifndef REP_POOL
#define REP_POOL 1
#endif
#ifndef REP_P2
#define REP_P2 1
#endif
#ifndef REP_P8
#define REP_P8 1
#endif
#ifndef REP_P4
#define REP_P4 1
#endif
#ifndef REP_SYNC
#define REP_SYNC 0
#endif
#ifndef REP_P0
#define REP_P0 1
#endif
#ifndef REP_P2B
#define REP_P2B 1
#endif
#ifndef REP_P7
#define REP_P7 1
#endif
#ifndef REP_SSD
#define REP_SSD 1
#endif
#ifndef REP_ATT
#define REP_ATT 1
#endif
#define PH(n) if ((PHM >> (n)) & 1)
#if defined(__HIP_DEVICE_COMPILE__)
#define LOADP() const __attribute__((address_space(4))) Params* pp_ = (const __attribute__((address_space(4))) Params*)__builtin_amdgcn_kernarg_segment_ptr(); asm volatile("" : "+s"(pp_)); const Params Q = *pp_; unsigned char* const ws = Q.ws; (void)ws;
#else
#define LOADP() const Params Q = P; unsigned char* const ws = Q.ws; (void)ws;
#endif
#define TIDS() int tid = MYTID(); asm volatile("" : "+v"(tid)); const int lane = tid & 63; const int wave = __builtin_amdgcn_readfirstlane(tid >> 6); \
    const int gw = bid * 8 + wave, ngw = G * 8, gtid = bid * NTHR + tid, ngt = G * NTHR; (void)lane; (void)gw; (void)ngw; (void)gtid; (void)ngt;

    for (int rep = 0; rep < REP_P0; ++rep) { LOADP(); TIDS();
      PH(0) phase_weights(Q, lds, gw, ngw, lane, wave);
      PH(1) phase_rope_table(Q, gtid, ngt);
      for (int m = gw; m < MROWS; m += 8 * ngw) rms_rows_bf16<8>(Q.x, Q.attn_norm, (bf16*)(ws + WS_H), m, ngw, lane); }
    grid.sync();
    (void)xcd_barrier_post((unsigned*)(P.ws + WS_CTL), xst, MYTID() == 0);
#define GSYNC() do { LOADP(); XcdBarrier xb_; xb_.bar = (unsigned*)(ws + WS_CTL); xb_.x = xb_xcc_id(); xb_.st = (volatile LAS unsigned*)((LAS unsigned char*)lds + MISC_OFF); xb_.t0 = (MYTID() == 0); xcd_barrier(xb_); } while (0)

    for (int l = 0; l < DEPTH; ++l) {
        for (int rep = 0; rep < REP_P2; ++rep) PH(2) { LOADP(); const unsigned char* wb = ws + WS_W + (size_t)l * W_LAYER; pg8::Gemm g{(const bf16*)(ws + WS_H), (const bf16*)(wb + WO_IN), MROWS, NINP, 1024}; pg8::StaticOrder S; S.init(MROWS, NINP, G, bid);
          pg8::EpiStoreBf16 E{(bf16*)(ws + WS_PROJ), NINP};
          pg8::gemm_phase<pg8::EpiStoreBf16, pg8::StaticOrder, true, true>(lds3, g, S, E, MYTID()); }
        GSYNC();
        for (int rep = 0; rep < REP_P2B; ++rep) { LOADP(); TIDS();
          bc_prepass(Q, l, gtid, ngt);
          for (int rep = 0; rep < REP_POOL; ++rep) PH(4) for (int it = bid; it < 256 * 4; it += G) pool_item(Q, l, it >> 2, it & 3, lds, tid);
          PH(5) for (int m = gw; m < MROWS; m += 8 * ngw) prep_rows<8>(Q, l, m, ngw, lane); }
        GSYNC();
        { LOADP(); TIDS();
          for (int rep = 0; rep < REP_SSD; ++rep) { PH(3) for (int it = vbid; it < NB * 16; it += G) ssd_item(Q, l, it >> 4, it & 15, lds, tid); } }
        GSYNC();
        for (int rep = 0; rep < REP_P4; ++rep) PH(6) { LOADP(); const unsigned char* wb = ws + WS_W + (size_t)l * W_LAYER; pg8::Gemm g{(const bf16*)(ws + WS_CQN), (const bf16*)(wb + WO_UQ), MROWS, 768, 384}; pg8::StaticOrder S; S.init(MROWS, 768, G, bid);
          pg8::EpiQRope E{(bf16*)(ws + WS_QB), 768, (const float*)(ws + WS_COS), (const float*)(ws + WS_SIN), 0.10206207261596575f * 1.4426950408889634f};
          pg8::gemm_phase<pg8::EpiQRope, pg8::StaticOrder, true, true>(lds3, g, S, E, MYTID()); }
        for (int rep = 0; rep < REP_P4; ++rep) PH(7) { LOADP(); const unsigned char* wb = ws + WS_W + (size_t)l * W_LAYER; pg8::Gemm g{(const bf16*)(ws + WS_CKVN), (const bf16*)(wb + WO_UKV), MROWS, 1024, 256}; pg8::StaticOrder S; S.init(MROWS, 1024, G, bid);
          pg8::EpiStoreBf16 E{(bf16*)(ws + WS_KVB), 1024};
          pg8::gemm_phase<pg8::EpiStoreBf16, pg8::StaticOrder, true, true>(lds3, g, S, E, MYTID()); }
        { LOADP(); TIDS();
          PH(8) for (int m = gw; m < MROWS; m += 8 * ngw) ssdnorm_rows<8>(Q, l, m, ngw, lane); }
        GSYNC();
        { LOADP(); TIDS();
          for (int rep = 0; rep < REP_ATT; ++rep) PH(9) for (int v = vbid; v < 256; v += G) {
            const int bh = v >> 1, par = v & 1;
            for (int i = 7; i >= 0; --i) { const int qb = 2 * i + ((i & 1) ^ par);
                attn_unit(Q, bh >> 3, bh & 7, qb, lds, tid); }
          } }
        GSYNC();
        PH(10) { LOADP(); const unsigned char* wb = ws + WS_W + (size_t)l * W_LAYER; pg8::Gemm g{(const bf16*)(ws + WS_MIX), (const bf16*)(wb + WO_OUT), MROWS, 1024, 2048}; pg8::StaticOrder S; S.init(MROWS, 1024, G, bid);
          pg8::EpiResF32 E{(l == 0) ? Q.x : Q.out, Q.out, 1024};
          pg8::gemm_phase<pg8::EpiResF32, pg8::StaticOrder, true, true>(lds3, g, S, E, MYTID()); }
        GSYNC();
        for (int rep = 0; rep < REP_SYNC; ++rep) GSYNC();
        for (int rep = 0; rep < REP_P7; ++rep) { LOADP(); TIDS();
          for (int m = gw; m < MROWS; m += 8 * ngw) rms_rows_bf16<8>(Q.out, Q.ffn_norm + l * DM, (bf16*)(ws + WS_H), m, ngw, lane); }
        GSYNC();
        for (int rep = 0; rep < REP_P8; ++rep) PH(11) { LOADP(); const unsigned char* wb = ws + WS_W + (size_t)l * W_LAYER; pg8::Gemm g{(const bf16*)(ws + WS_H), (const bf16*)(wb + WO_UP), MROWS, 5632, 1024}; pg8::StaticOrder S; S.init(MROWS, 5632, G, bid);
          pg8::EpiFfnConv E{(bf16*)(ws + WS_ACT), (float*)(ws + WS_RAW), Q.ffn_conv_w + (size_t)l * 3 * 5632, Q.ffn_conv_b + (size_t)l * 5632};
          pg8::gemm_phase<pg8::EpiFfnConv, pg8::StaticOrder, true, true>(lds3, g, S, E, MYTID()); }
        GSYNC();
        { LOADP(); TIDS();
          PH(12) ffn_fixup(Q, l, gtid, ngt); }
        GSYNC();
        PH(13) { LOADP(); const unsigned char* wb = ws + WS_W + (size_t)l * W_LAYER; pg8::Gemm g{(const bf16*)(ws + WS_ACT), (const bf16*)(wb + WO_DOWN), MROWS, 1024, 2816}; pg8::StaticOrder S; S.init(MROWS, 1024, G, bid, 1);
          pg8::EpiResF32 E{Q.out, Q.out, 1024};
          pg8::gemm_phase<pg8::EpiResF32, pg8::StaticOrder, true, true>(lds3, g, S, E, MYTID()); }
        GSYNC();
        { LOADP(); TIDS();
          if (l + 1 < DEPTH) {
            for (int m = gw; m < MROWS; m += 8 * ngw) rms_rows_bf16<8>(Q.out, Q.attn_norm + (l + 1) * DM, (bf16*)(ws + WS_H), m, ngw, lane);
          } else {
            for (int m = gw; m < MROWS; m += 8 * ngw) rms_rows_f32<8>(Q.out, Q.final_norm, m, ngw, lane);
          } }
        if (l + 1 < DEPTH) GSYNC();
    }
}

extern "C" void kernel_launch(void* const* d_in, const int* in_sizes, int n_in, void* d_out, int out_size, void* d_ws, size_t ws_size, hipStream_t stream) {
    static int grid = 0;
    if (grid == 0) {
        if (n_in != 23 || ws_size < WS_END) { fprintf(stderr, "kernel_launch: unexpected inputs (n_in %d, ws %zu)\n", n_in, ws_size); grid = -1; return; }
        int dev = 0, cus = 0, per_cu = 0;
        hipGetDevice(&dev); hipDeviceGetAttribute(&cus, hipDeviceAttributeMultiprocessorCount, dev);
        hipFuncSetAttribute((const void*)fwd_kernel, hipFuncAttributeMaxDynamicSharedMemorySize, LDS_BYTES);
        hipOccupancyMaxActiveBlocksPerMultiprocessor(&per_cu, (const void*)fwd_kernel, NTHR, LDS_BYTES);
        if (per_cu < 1) per_cu = 1;
        grid = cus * per_cu;
        (void)hipGetLastError();
    }
    if (grid < 0) return;
    Params p{};
    p.x = (const float*)d_in[0]; p.pos = (const int*)d_in[1]; p.attn_norm = (const float*)d_in[2]; p.w_in = (const float*)d_in[3];
    p.ssd_conv_w = (const float*)d_in[4]; p.ssd_conv_b = (const float*)d_in[5]; p.ssd_dt_bias = (const float*)d_in[6]; p.ssd_a_log = (const float*)d_in[7];
    p.ssd_d = (const float*)d_in[8]; p.ssd_norm = (const float*)d_in[9]; p.pool_w = (const float*)d_in[10]; p.pool_scale = (const float*)d_in[11];
    p.q_norm = (const float*)d_in[12]; p.w_uq = (const float*)d_in[13]; p.kv_norm = (const float*)d_in[14]; p.w_ukv = (const float*)d_in[15];
    p.w_out = (const float*)d_in[16]; p.ffn_norm = (const float*)d_in[17]; p.w_up = (const float*)d_in[18]; p.ffn_conv_w = (const float*)d_in[19];
    p.ffn_conv_b = (const float*)d_in[20]; p.w_down = (const float*)d_in[21]; p.final_norm = (const float*)d_in[22];
    p.out = (float*)d_out; p.ws = (unsigned char*)d_ws;
    void* args[] = {&p};
    hipError_t e = hipLaunchCooperativeKernel((const void*)fwd_kernel, dim3(grid), dim3(NTHR), args, LDS_BYTES, stream);
    if (e != hipSuccess) fprintf(stderr, "cooperative launch failed: %s (grid %d)\n", hipGetErrorString(e), grid);
}
```

```cpp
#include <hip/hip_runtime.h>
#include <hip/hip_cooperative_groups.h>
#include <cstdio>
#include <cstdint>
namespace cg = cooperative_groups;
namespace pg8 {
#define PG8_LAS __attribute__((address_space(3)))
typedef unsigned short bf16_t;
typedef short bf16x8 __attribute__((ext_vector_type(8)));
typedef float f32x4 __attribute__((ext_vector_type(4)));
typedef unsigned u32x4 __attribute__((ext_vector_type(4)));
constexpr int BM = 256, BK = 64, HALF = 128, HTB = HALF * BK * 2  , STAGE_BYTES = 8 * HTB, NXCD = 8, WGM = 8;

__host__ __device__ __forceinline__ int lds_byte(int r, int c) { const int st = (r >> 4) * 2 + (c >> 5), rr = r & 15, cc = c & 31, ob = rr * 64 + cc * 2; return st * 1024 + (ob ^ (((ob >> 9) & 1) << 5)); }
__host__ __device__ __forceinline__ void stage_rc(int b, int& R, int& C) { const int st = b / 1024, sb = b % 1024, swz = sb ^ (((sb >> 9) & 1) << 5); R = (st >> 1) * 16 + swz / 64; C = (st & 1) * 32 + (swz % 64) / 2; }
__host__ __device__ __forceinline__ int perm32(int rho) { const int n = rho >> 4, i = rho & 15; return 8 * (i >> 2) + 4 * n + (i & 3); }

struct Unit { int pm, pn; };
struct Gemm { const bf16_t* A; const bf16_t* Bt; int M, N, K; };

struct StaticOrder {
    int nM, nN, nwg, G, c, rev;
    __host__ __device__ void init(int M, int N, int G_, int c_, int rev_ = 0) { nM = M / BM; nN = N / BM; nwg = nM * nN; G = G_; c = c_; rev = rev_; }
    __host__ __device__ bool next(int i, Unit& u) const {
        const long L = (long)i * G + c; if (L >= nwg) return false;
        int wgid = (int)L; { const int q = nwg / NXCD, r = nwg % NXCD, xcd = wgid % NXCD, off = wgid / NXCD; wgid = (xcd < r ? xcd * (q + 1) : r * (q + 1) + (xcd - r) * q) + off; }
        const int nig = WGM * nN, gid = wgid / nig, fm = gid * WGM, gsz = (nM - fm) < WGM ? (nM - fm) : WGM;
        u.pm = fm + ((wgid % nig) % gsz); u.pn = (wgid % nig) / gsz; if (rev) u.pm = nM - 1 - u.pm; return true;
    }
    __device__ __forceinline__ void a_ready(const Unit&) const {}
    __device__ __forceinline__ void done(const Unit&) const {}
};

__device__ __forceinline__ unsigned cvt_pk_bf16(float lo, float hi) { unsigned r; asm("v_cvt_pk_bf16_f32 %0, %1, %2" : "=v"(r) : "v"(lo), "v"(hi)); return r; }
typedef float f32x2 __attribute__((ext_vector_type(2)));
typedef unsigned u32x2 __attribute__((ext_vector_type(2)));
__device__ __forceinline__ float fast_silu(float v) { return v * __builtin_amdgcn_rcpf(1.0f + __builtin_amdgcn_exp2f(-1.4426950408889634f * v)); }

struct EpiStoreBf16 {
    static constexpr bool PERM = true, AFTER_DRAIN = false;
    bf16_t* O; int ldc;
    __device__ __forceinline__ void operator()(const f32x4 (&acc)[2][2][4][2], const Unit& u, int wr, int wc, int fr, int fq) const {
        const int row0 = u.pm * BM + wr * 64 + fr; const int col0 = u.pn * BM + wc * 32 + 8 * fq;
#pragma unroll
        for (int ai = 0; ai < 2; ++ai)
#pragma unroll
            for (int m = 0; m < 4; ++m) { bf16_t* rowp = O + (size_t)(row0 + ai * HALF + m * 16) * ldc + col0;
#pragma unroll
                for (int bj = 0; bj < 2; ++bj) { const f32x4 v0 = acc[ai][bj][m][0], v1 = acc[ai][bj][m][1];
                    u32x4 w; w.x = cvt_pk_bf16(v0[0], v0[1]); w.y = cvt_pk_bf16(v0[2], v0[3]); w.z = cvt_pk_bf16(v1[0], v1[1]); w.w = cvt_pk_bf16(v1[2], v1[3]);
                    *(u32x4*)(rowp + bj * HALF) = w; } }
    }
};
struct EpiResF32 {
    static constexpr bool PERM = false, AFTER_DRAIN = false;
    const float* base; float* out; int ldc;
    __device__ __forceinline__ void operator()(const f32x4 (&acc)[2][2][4][2], const Unit& u, int wr, int wc, int fr, int fq) const {
        const int row0 = u.pm * BM + wr * 64 + fr; const int col0 = u.pn * BM + wc * 32 + 4 * fq;
#pragma unroll
        for (int ai = 0; ai < 2; ++ai)
#pragma unroll
            for (int m = 0; m < 4; ++m) { const size_t off = (size_t)(row0 + ai * HALF + m * 16) * ldc + col0;
#pragma unroll
                for (int bj = 0; bj < 2; ++bj)
#pragma unroll
                    for (int n = 0; n < 2; ++n) { const f32x4 b = *(const f32x4*)(base + off + bj * HALF + n * 16); *(f32x4*)(out + off + bj * HALF + n * 16) = b + acc[ai][bj][m][n]; } }
    }
};
struct EpiQRope {
    static constexpr bool PERM = false, AFTER_DRAIN = false;
    bf16_t* O; int ldc; const float* cosT; const float* sinT; float qscale;
    __device__ __forceinline__ void operator()(const f32x4 (&acc)[2][2][4][2], const Unit& u, int wr, int wc, int fr, int fq) const {
        asm volatile("" : "+v"(fr), "+v"(fq));
        const int row0 = u.pm * BM + wr * 64 + fr;
#pragma unroll
        for (int ai = 0; ai < 2; ++ai)
#pragma unroll
            for (int m = 0; m < 4; ++m) { const int row = row0 + ai * HALF + m * 16;
                const f32x4 cs = *(const f32x4*)(cosT + (size_t)row * 16 + 4 * fq), sn = *(const f32x4*)(sinT + (size_t)row * 16 + 4 * fq);
#pragma unroll
                for (int bj = 0; bj < 2; ++bj) { const int cb = u.pn * BM + bj * HALF + wc * 32; const bool rp = ((cb >> 5) % 3) == 2;
                    f32x4 x1 = acc[ai][bj][m][0], x2 = acc[ai][bj][m][1];
                    if (rp) { const f32x4 a = x1 * cs - x2 * sn, b = x1 * sn + x2 * cs; x1 = a; x2 = b; }
                    x1 = x1 * qscale; x2 = x2 * qscale;
                    bf16_t* p = O + (size_t)row * ldc + cb + 4 * fq;
                    u32x2 w0, w1; w0.x = cvt_pk_bf16(x1[0], x1[1]); w0.y = cvt_pk_bf16(x1[2], x1[3]); w1.x = cvt_pk_bf16(x2[0], x2[1]); w1.y = cvt_pk_bf16(x2[2], x2[3]);
                    *(u32x2*)p = w0; *(u32x2*)(p + 16) = w1; }
                asm volatile("" ::: "memory"); }
    }
};
template <int CTRL> __device__ __forceinline__ float dpp_mov(float old, float src) {
    return __builtin_bit_cast(float, __builtin_amdgcn_update_dpp(__builtin_bit_cast(int, old), __builtin_bit_cast(int, src), CTRL, 0xF, 0xF, false));
}
template <int CTRL> __device__ __forceinline__ float ror_dpp(float src) { return __builtin_bit_cast(float, __builtin_amdgcn_mov_dpp(__builtin_bit_cast(int, src), CTRL, 0xF, 0xF, true)); }
struct EpiFfnConv {
    static constexpr bool PERM = true, AFTER_DRAIN = false;
    bf16_t* ACT; float* RAW; const float* cw; const float* cb;
    __device__ __forceinline__ void operator()(const f32x4 (&acc)[2][2][4][2], const Unit& u, int wr, int wc, int fr, int fq) const {
        asm volatile("" : "+v"(fr), "+v"(fq));
        const int rc0 = wc * 32 + 8 * fq;
        const int gch = u.pn * HALF + rc0;
        if (fr < 2 || fr >= 14) {
#pragma unroll
            for (int ai = 0; ai < 2; ++ai) {
                const int blk = (u.pm * BM + ai * HALF + wr * 64) >> 6;
                const int slot = fr < 2 ? fr : fr - 12;
                float* rp = RAW + ((size_t)blk * 4 + slot) * 5632 + u.pn * BM + rc0;
#pragma unroll
                for (int bj = 0; bj < 2; ++bj)
#pragma unroll
                    for (int n = 0; n < 2; ++n) *(f32x4*)(rp + bj * HALF + 4 * n) = (fr < 2) ? acc[ai][bj][0][n] : acc[ai][bj][3][n];
            }
        }
        asm volatile("" ::: "memory");
        const int row0 = u.pm * BM + wr * 64 + fr;
        const bool is15 = (fr == 15), ge14 = (fr >= 14);
#pragma unroll
        for (int n = 0; n < 2; ++n) {
            const int ch = gch + 4 * n;
            const f32x4 gw0 = *(const f32x4*)(cw + ch), gw1 = *(const f32x4*)(cw + 5632 + ch), gw2 = *(const f32x4*)(cw + 2 * 5632 + ch), gbb = *(const f32x4*)(cb + ch);
            const f32x4 vw0 = *(const f32x4*)(cw + 2816 + ch), vw1 = *(const f32x4*)(cw + 5632 + 2816 + ch), vw2 = *(const f32x4*)(cw + 2 * 5632 + 2816 + ch), vbb = *(const f32x4*)(cb + 2816 + ch);
#pragma unroll
            for (int ai = 0; ai < 2; ++ai)
#pragma unroll
                for (int m = 0; m < 4; ++m) {
                    const f32x4 gc = acc[ai][0][m][n], vc = acc[ai][1][m][n];
                    f32x4 gp = (f32x4){0.f, 0.f, 0.f, 0.f}, vp = gp; if (m > 0) { gp = acc[ai][0][m - 1][n]; vp = acc[ai][1][m - 1][n]; }
                    f32x4 a;
#pragma unroll
                    for (int j = 0; j < 4; ++j) {
                        const float gm1 = is15 ? gp[j] : gc[j], gm2 = ge14 ? gp[j] : gc[j], vm1 = is15 ? vp[j] : vc[j], vm2 = ge14 ? vp[j] : vc[j];
                        float gg = gbb[j] + gw2[j] * gc[j], vv = vbb[j] + vw2[j] * vc[j];
                        asm volatile("s_nop 1\n\tv_fmac_f32_dpp %0, %2, %3 row_ror:1 row_mask:0xf bank_mask:0xf\n\tv_fmac_f32_dpp %1, %4, %5 row_ror:1 row_mask:0xf bank_mask:0xf"
                                     : "+v"(gg), "+v"(vv) : "v"(gm1), "v"(gw1[j]), "v"(vm1), "v"(vw1[j]));
                        asm volatile("s_nop 1\n\tv_fmac_f32_dpp %0, %2, %3 row_ror:2 row_mask:0xf bank_mask:0xf\n\tv_fmac_f32_dpp %1, %4, %5 row_ror:2 row_mask:0xf bank_mask:0xf"
                                     : "+v"(gg), "+v"(vv) : "v"(gm2), "v"(gw0[j]), "v"(vm2), "v"(vw0[j]));
                        a[j] = fast_silu(gg) * vv;
                    }
                    u32x2 w; w.x = cvt_pk_bf16(a[0], a[1]); w.y = cvt_pk_bf16(a[2], a[3]);
                    *(u32x2*)(ACT + (size_t)(row0 + ai * HALF + m * 16) * 2816 + ch) = w;
                }
            asm volatile("" ::: "memory");
        }
    }
};
template <class Epi, class Sched, bool ALIGN_EPI = false, bool SP2 = false>
__device__ __forceinline__ void gemm_phase(PG8_LAS unsigned char* lds, const Gemm g, const Sched& S, const Epi& E, const int tid_in) {
    int tid_ = tid_in; asm volatile("" : "+v"(tid_)); const int tid = tid_, wid = __builtin_amdgcn_readfirstlane(tid >> 6), lane = tid & 63, wr = wid >> 2, wc = wid & 3, fr = lane & 15, fq = lane >> 4;
    int K_ = g.K; asm volatile("" : "+s"(K_)); const int K = K_, nt = K / BK;
    unsigned voffA[2], voffB[2];
#pragma unroll
    for (int i = 0; i < 2; ++i) { int R, C; stage_rc(tid * 16 + i * 8192, R, C); const int Rb = Epi::PERM ? ((R & ~31) + perm32(R & 31)) : R;
        voffA[i] = (unsigned)(R * K + C) * 2u; voffB[i] = (unsigned)(Rb * K + C) * 2u; }
    const size_t kstep = (size_t)(BK * 2);
    const size_t hstep = (size_t)HALF * K * 2;
    const size_t tstep = 2 * hstep;
    const unsigned ldsw = (unsigned)wid * 1024u;
    const int aoff = lds_byte(wr * 64 + fr, fq * 8), boff = lds_byte(wc * 32 + fr, fq * 8);
#define PG8_SA(b, h) (((b) * 2 + (h)) * HTB)
#define PG8_SB(b, h) ((4 + (b) * 2 + (h)) * HTB)
#define PG8_STAGE(bufoff, gbase, voff) do { _Pragma("unroll") for (int _i = 0; _i < 2; ++_i) \
        __builtin_amdgcn_global_load_lds((const unsigned*)((const char*)(gbase) + (voff)[_i]), (PG8_LAS unsigned*)(lds + (bufoff) + ldsw + _i * 8192), 16, 0, 0); } while (0)
#define PG8_LDA(dst, b, h) do { _Pragma("unroll") for (int m = 0; m < 4; ++m) _Pragma("unroll") for (int k = 0; k < 2; ++k) dst[m][k] = *(const PG8_LAS bf16x8*)(lds + PG8_SA(b, h) + aoff + m * 2048 + k * 1024); } while (0)
#define PG8_LDB(dst, b, h) do { _Pragma("unroll") for (int n = 0; n < 2; ++n) _Pragma("unroll") for (int k = 0; k < 2; ++k) dst[n][k] = *(const PG8_LAS bf16x8*)(lds + PG8_SB(b, h) + boff + n * 2048 + k * 1024); } while (0)
#define PG8_MMA(ai, bj, At, Bt) do { __builtin_amdgcn_s_setprio(1); _Pragma("unroll") for (int m = 0; m < 4; ++m) _Pragma("unroll") for (int n = 0; n < 2; ++n) _Pragma("unroll") for (int k = 0; k < 2; ++k) \
        acc[ai][bj][m][n] = __builtin_amdgcn_mfma_f32_16x16x32_bf16(Bt[n][k], At[m][k], acc[ai][bj][m][n], 0, 0, 0); __builtin_amdgcn_s_setprio(0); } while (0)
#define PG8_WAIT_V(n) asm volatile("s_waitcnt vmcnt(" #n ")" ::: "memory")
#define PG8_WAIT_L(n) asm volatile("s_waitcnt lgkmcnt(" #n ")" ::: "memory")
#define PG8_BAR __builtin_amdgcn_s_barrier()
#define PG8_SCHED __builtin_amdgcn_sched_barrier(0)
    Unit cur, nxt; int ui = 0;
    if (!S.next(0, cur)) return;
    f32x4 acc[2][2][4][2];
#pragma unroll
    for (int a = 0; a < 2; ++a)
#pragma unroll
        for (int b = 0; b < 2; ++b)
#pragma unroll
            for (int m = 0; m < 4; ++m)
#pragma unroll
                for (int n = 0; n < 2; ++n) acc[a][b][m][n] = (f32x4){0.f, 0.f, 0.f, 0.f};
    bf16x8 At[4][2], B0[2][2], B1[2][2];
    const char* cA = (const char*)g.A + (size_t)cur.pm * tstep; const char* cB = (const char*)g.Bt + (size_t)cur.pn * tstep;
    S.a_ready(cur);
    if constexpr (SP2) {
        PG8_STAGE(PG8_SB(0, 0), cB, voffB); PG8_STAGE(PG8_SB(0, 1), cB + hstep, voffB); PG8_STAGE(PG8_SA(0, 0), cA, voffA); PG8_STAGE(PG8_SA(0, 1), cA + hstep, voffA);
        if (wr == 1) PG8_BAR;
        PG8_WAIT_V(2); PG8_BAR;
        PG8_STAGE(PG8_SB(1, 0), cB + kstep, voffB); PG8_STAGE(PG8_SA(1, 0), cA + kstep, voffA); PG8_STAGE(PG8_SB(1, 1), cB + hstep + kstep, voffB);
        PG8_WAIT_V(6); PG8_BAR;
    } else {
        PG8_STAGE(PG8_SB(0, 0), cB, voffB); PG8_STAGE(PG8_SA(0, 0), cA, voffA); PG8_STAGE(PG8_SB(0, 1), cB + hstep, voffB); PG8_STAGE(PG8_SA(0, 1), cA + hstep, voffA);
        if (wr == 1) PG8_BAR;
        PG8_WAIT_V(4); PG8_BAR;
        PG8_STAGE(PG8_SB(1, 0), cB + kstep, voffB); PG8_STAGE(PG8_SA(1, 0), cA + kstep, voffA); PG8_STAGE(PG8_SB(1, 1), cB + hstep + kstep, voffB);
        PG8_WAIT_V(6); PG8_BAR;
    }
    for (;;) {
        const bool has_next = S.next(ui + 1, nxt);
        const char* nA = has_next ? (const char*)g.A + (size_t)nxt.pm * tstep : cA; const char* nB = has_next ? (const char*)g.Bt + (size_t)nxt.pn * tstep : cB;
        for (int t = 0; t < nt; t += 2) {
            const bool last = (t == nt - 2);
            const char* a1 = cA + (size_t)(t + 1) * kstep;
            const char* a2 = last ? nA : cA + (size_t)(t + 2) * kstep; const char* b2 = last ? nB : cB + (size_t)(t + 2) * kstep;
            const char* a3 = a2 + kstep; const char* b3 = b2 + kstep;
            if (last && has_next) S.a_ready(nxt);
            if constexpr (SP2) {
            PG8_LDB(B0, 0, 0); PG8_LDB(B1, 0, 1); PG8_SCHED; PG8_LDA(At, 0, 0); PG8_STAGE(PG8_SA(1, 1), a1 + hstep, voffA);
            PG8_WAIT_V(8); PG8_WAIT_L(0); PG8_BAR; PG8_MMA(0, 0, At, B0); PG8_MMA(0, 1, At, B1); PG8_BAR; PG8_SCHED;
            PG8_LDA(At, 0, 1); PG8_STAGE(PG8_SB(0, 0), b2, voffB); PG8_STAGE(PG8_SB(0, 1), b2 + hstep, voffB); PG8_STAGE(PG8_SA(0, 0), a2, voffA);
            PG8_WAIT_V(8); PG8_WAIT_L(0); PG8_BAR; PG8_MMA(1, 0, At, B0); PG8_MMA(1, 1, At, B1); PG8_BAR; PG8_SCHED;
            PG8_LDB(B0, 1, 0); PG8_LDB(B1, 1, 1); PG8_SCHED; PG8_LDA(At, 1, 0); PG8_STAGE(PG8_SA(0, 1), a2 + hstep, voffA);
            PG8_WAIT_V(8); PG8_WAIT_L(0); PG8_BAR; PG8_MMA(0, 0, At, B0); PG8_MMA(0, 1, At, B1); PG8_BAR; PG8_SCHED;
            PG8_LDA(At, 1, 1); PG8_STAGE(PG8_SB(1, 0), b3, voffB); PG8_STAGE(PG8_SB(1, 1), b3 + hstep, voffB); PG8_STAGE(PG8_SA(1, 0), a3, voffA);
            PG8_WAIT_V(8); PG8_WAIT_L(0); PG8_BAR; PG8_MMA(1, 0, At, B0); PG8_MMA(1, 1, At, B1); PG8_BAR; PG8_SCHED;
            } else {
            PG8_LDB(B0, 0, 0); PG8_SCHED; PG8_LDA(At, 0, 0); PG8_STAGE(PG8_SA(1, 1), a1 + hstep, voffA);
            PG8_WAIT_L(8); PG8_BAR; PG8_WAIT_L(0); PG8_MMA(0, 0, At, B0); PG8_BAR; PG8_SCHED;
            PG8_LDB(B1, 0, 1); PG8_STAGE(PG8_SB(0, 0), b2, voffB);
            PG8_BAR; PG8_WAIT_L(0); PG8_MMA(0, 1, At, B1); PG8_BAR;
            PG8_LDA(At, 0, 1); PG8_STAGE(PG8_SA(0, 0), a2, voffA);
            PG8_BAR; PG8_WAIT_L(0); PG8_MMA(1, 0, At, B0); PG8_BAR; PG8_SCHED;
            PG8_STAGE(PG8_SB(0, 1), b2 + hstep, voffB);
            PG8_WAIT_V(6); PG8_BAR; PG8_MMA(1, 1, At, B1); PG8_BAR;
            PG8_LDB(B0, 1, 0); PG8_SCHED; PG8_LDA(At, 1, 0); PG8_STAGE(PG8_SA(0, 1), a2 + hstep, voffA);
            PG8_WAIT_L(8); PG8_BAR; PG8_WAIT_L(0); PG8_MMA(0, 0, At, B0); PG8_BAR; PG8_SCHED;
            PG8_LDB(B1, 1, 1); PG8_STAGE(PG8_SB(1, 0), b3, voffB);
            PG8_BAR; PG8_WAIT_L(0); PG8_MMA(0, 1, At, B1); PG8_BAR;
            PG8_LDA(At, 1, 1); PG8_STAGE(PG8_SA(1, 0), a3, voffA);
            PG8_BAR; PG8_WAIT_L(0); PG8_MMA(1, 0, At, B0); PG8_BAR; PG8_SCHED;
            PG8_STAGE(PG8_SB(1, 1), b3 + hstep, voffB);
            PG8_WAIT_V(6); PG8_BAR; PG8_MMA(1, 1, At, B1); PG8_BAR;
            }
        }
        if constexpr (ALIGN_EPI) { if (wr == 0) PG8_BAR; }
        if constexpr (!Epi::AFTER_DRAIN) { E(acc, cur, wr, wc, fr, fq); S.done(cur); }
        if (!has_next) break;
#pragma unroll
        for (int a = 0; a < 2; ++a)
#pragma unroll
            for (int b = 0; b < 2; ++b)
#pragma unroll
                for (int m = 0; m < 4; ++m)
#pragma unroll
                    for (int n = 0; n < 2; ++n) acc[a][b][m][n] = (f32x4){0.f, 0.f, 0.f, 0.f};
        cur = nxt; cA = nA; cB = nB; ++ui;
        if constexpr (ALIGN_EPI) { if (wr == 1) PG8_BAR; }
    }
    PG8_WAIT_V(0);
    if constexpr (!ALIGN_EPI) { if (wr == 0) PG8_BAR; }
    PG8_BAR;
    if constexpr (Epi::AFTER_DRAIN) { E.fused(acc, cur, wr, wc, fr, fq, lds, wid, lane); S.done(cur); }
#undef PG8_SA
#undef PG8_SB
#undef PG8_STAGE
#undef PG8_LDA
#undef PG8_LDB
#undef PG8_MMA
#undef PG8_WAIT_V
#undef PG8_WAIT_L
#undef PG8_BAR
#undef PG8_SCHED
}
}
constexpr int NB = 16, SEQ = 4096, DM = 1024, MROWS = NB * SEQ, DEPTH = 2;
constexpr int NIN = 3760, NINP = 3840;
constexpr int COL_Z = 0, COL_XBC = 1024, COL_DT = 2560, COL_U = 2576, COL_CQ = 3088, COL_CKV = 3472, COL_KPE = 3728;
constexpr int DFF = 2816, MIXW = 2048;
constexpr float EPS = 1e-6f;
constexpr size_t MiB = 1u << 20;
constexpr size_t WS_H = 0, WS_CQN = 0, WS_CKVN = 48 * MiB, WS_KPE = 80 * MiB;
constexpr size_t WS_PROJ = 128 * MiB, WS_QB = WS_PROJ, WS_KVB = WS_PROJ + 96 * MiB, WS_ACT = WS_PROJ;
constexpr size_t WS_MIX = 608 * MiB, WS_RAW = WS_MIX;
constexpr size_t WS_W = 864 * MiB, W_LAYER = 30 * MiB;
constexpr size_t WO_IN = 0, WO_OUT = WO_IN + (size_t)NINP * 1024 * 2, WO_UP = WO_OUT + (size_t)1024 * 2048 * 2, WO_DOWN = WO_UP + (size_t)5632 * 1024 * 2,
                 WO_UQ = WO_DOWN + (size_t)1024 * 2816 * 2, WO_UKV = WO_UQ + (size_t)768 * 384 * 2, WO_POOL = WO_UKV + (size_t)1024 * 256 * 2, WO_END = WO_POOL + (size_t)4 * 128 * 128 * 2;
static_assert(WO_END <= W_LAYER, "weights fit");
constexpr size_t WS_COS = 926 * MiB, WS_SIN = 930 * MiB, WS_CTL = 934 * MiB, WS_BC = 935 * MiB  , WS_END = 999 * MiB;
constexpr int MISC_OFF = 140000;
constexpr int LDS_BYTES = 147456;
constexpr int NTHR = 512;

typedef unsigned short bf16;
typedef unsigned v4u __attribute__((ext_vector_type(4)));
typedef unsigned v2u __attribute__((ext_vector_type(2)));
typedef float f32x4 __attribute__((ext_vector_type(4)));
typedef float f32x16 __attribute__((ext_vector_type(16)));
typedef short bf16x8 __attribute__((ext_vector_type(8)));
typedef short s16x4 __attribute__((ext_vector_type(4)));
#define LAS __attribute__((address_space(3)))
#define LBAR() asm volatile("s_waitcnt lgkmcnt(0)\n\ts_barrier" ::: "memory")

__device__ __forceinline__ unsigned f2bf(float f) { unsigned u = __builtin_bit_cast(unsigned, f); return (u + 0x7fffu + ((u >> 16) & 1u)) >> 16; }
__device__ __forceinline__ unsigned pk2(float lo, float hi) { return pg8::cvt_pk_bf16(lo, hi); }
__device__ __forceinline__ float bflo(unsigned w) { return __builtin_bit_cast(float, w << 16); }
__device__ __forceinline__ float bfhi(unsigned w) { return __builtin_bit_cast(float, w & 0xffff0000u); }
__device__ __forceinline__ float bf1(bf16 h) { return __builtin_bit_cast(float, (unsigned)h << 16); }
__device__ __forceinline__ float wave_sum(float v) {
#pragma unroll
    for (int o = 1; o < 64; o <<= 1) v += __shfl_xor(v, o);
    return v;
}
__device__ __forceinline__ float silu_f(float v) { return v / (1.0f + __expf(-v)); }

struct Params {
    const float* x; const int* pos; const float* attn_norm; const float* w_in; const float* ssd_conv_w; const float* ssd_conv_b; const float* ssd_dt_bias; const float* ssd_a_log;
    const float* ssd_d; const float* ssd_norm; const float* pool_w; const float* pool_scale; const float* q_norm; const float* w_uq; const float* kv_norm; const float* w_ukv;
    const float* w_out; const float* ffn_norm; const float* w_up; const float* ffn_conv_w; const float* ffn_conv_b; const float* w_down; const float* final_norm;
    float* out; unsigned char* ws;
};

__device__ __forceinline__ void transpose_item(const float* W, int K, int N, bf16* WT, int mode, float* scr, int item, int lane, int nblk) {
    const int kb = item / nblk, nb = item % nblk, k0 = 64 * kb, n0 = 32 * nb;
    { const int n4 = n0 + 4 * (lane & 7), kr = lane >> 3; f32x4 v[8];
#pragma unroll
      for (int i = 0; i < 8; ++i) v[i] = (n4 < N) ? *(const f32x4*)(W + (size_t)(k0 + 8 * i + kr) * N + n4) : (f32x4){0.f, 0.f, 0.f, 0.f};
#pragma unroll
      for (int i = 0; i < 8; ++i) { float* d = scr + (8 * i + kr) * 33 + 4 * (lane & 7); d[0] = v[i][0]; d[1] = v[i][1]; d[2] = v[i][2]; d[3] = v[i][3]; } }
    asm volatile("s_waitcnt lgkmcnt(0)" ::: "memory");
    const int c = lane & 7;
#pragma unroll
    for (int j = 0; j < 4; ++j) { const int n = (lane >> 3) + 8 * j; const float* s = scr + (8 * c) * 33 + n;
        v4u o; o.x = pk2(s[0 * 33], s[1 * 33]); o.y = pk2(s[2 * 33], s[3 * 33]); o.z = pk2(s[4 * 33], s[5 * 33]); o.w = pk2(s[6 * 33], s[7 * 33]);
        int gn = n0 + n; int dr = gn;
        if (mode == 1) { dr = (gn < DFF) ? ((gn >> 7) * 256 + (gn & 127)) : (((gn - DFF) >> 7) * 256 + 128 + ((gn - DFF) & 127)); }
        *(v4u*)(WT + (size_t)dr * K + k0 + 8 * c) = o; }
    asm volatile("s_waitcnt lgkmcnt(0)" ::: "memory");
}
__device__ __forceinline__ void phase_weights(const Params& P, unsigned char* lds, int gw, int ngw, int lane, int wave) {
    float* scr = (float*)(lds + wave * 16384);
    for (int l = 0; l < DEPTH; ++l) {
        unsigned char* wb = P.ws + WS_W + (size_t)l * W_LAYER;
        const int i_in = (1024 / 64) * (NINP / 32), i_out = (2048 / 64) * (1024 / 32), i_up = (1024 / 64) * (5632 / 32), i_dn = (2816 / 64) * (1024 / 32), i_uq = (384 / 64) * (768 / 32), i_ukv = (256 / 64) * (1024 / 32), i_pool = 4 * 8;
        const int tot = i_in + i_out + i_up + i_dn + i_uq + i_ukv + i_pool;
        for (int it = gw; it < tot; it += ngw) {
            int r = it;
            if (r < i_in) { transpose_item(P.w_in + (size_t)l * 1024 * NIN, 1024, NIN, (bf16*)(wb + WO_IN), 0, scr, r, lane, NINP / 32); continue; } r -= i_in;
            if (r < i_out) { transpose_item(P.w_out + (size_t)l * 2048 * 1024, 2048, 1024, (bf16*)(wb + WO_OUT), 0, scr, r, lane, 1024 / 32); continue; } r -= i_out;
            if (r < i_up) { transpose_item(P.w_up + (size_t)l * 1024 * 5632, 1024, 5632, (bf16*)(wb + WO_UP), 1, scr, r, lane, 5632 / 32); continue; } r -= i_up;
            if (r < i_dn) { transpose_item(P.w_down + (size_t)l * 2816 * 1024, 2816, 1024, (bf16*)(wb + WO_DOWN), 0, scr, r, lane, 1024 / 32); continue; } r -= i_dn;
            if (r < i_uq) { transpose_item(P.w_uq + (size_t)l * 384 * 768, 384, 768, (bf16*)(wb + WO_UQ), 0, scr, r, lane, 768 / 32); continue; } r -= i_uq;
            if (r < i_ukv) { transpose_item(P.w_ukv + (size_t)l * 256 * 1024, 256, 1024, (bf16*)(wb + WO_UKV), 0, scr, r, lane, 1024 / 32); continue; } r -= i_ukv;
            transpose_item(P.pool_w + ((size_t)l * 4 + (r >> 3)) * 128 * 128, 128, 128, (bf16*)(wb + WO_POOL) + (size_t)(r >> 3) * 128 * 128, 0, scr, r & 7, lane, 4);
        }
    }
}
__constant__ double INV_FREQ[16] = {1.0, 0.5623413251903491, 0.31622776601683794, 0.1778279410038923, 0.1, 0.05623413251903491, 0.03162277660168379, 0.01778279410038923,
                                    0.01, 0.005623413251903491, 0.0031622776601683794, 0.0017782794100389228, 0.001, 0.0005623413251903491, 0.00031622776601683794, 0.00017782794100389227};
__device__ __forceinline__ void phase_rope_table(const Params& P, int gtid, int ngt) {
    float* cosT = (float*)(P.ws + WS_COS); float* sinT = (float*)(P.ws + WS_SIN);
    for (int i = gtid; i < MROWS * 16; i += ngt) {
        const int row = i >> 4, f = i & 15;
        const double ang = (double)P.pos[row] * INV_FREQ[f];
        const double k = __builtin_rint(ang * 0.15915494309189535);
        const float r = (float)(ang - k * 6.283185307179586);
        cosT[i] = __cosf(r) ; sinT[i] = __sinf(r);
    }
}
template <int NR> __device__ __forceinline__ void rms_rows_bf16(const float* x, const float* w, bf16* o, int m0, int mstride, int lane) {
    f32x4 v[NR][4]; float s[NR];
#pragma unroll
    for (int r = 0; r < NR; ++r) { const f32x4* xr = (const f32x4*)(x + (size_t)(m0 + r * mstride) * DM) + lane;
#pragma unroll
        for (int j = 0; j < 4; ++j) v[r][j] = xr[64 * j]; }
#pragma unroll
    for (int r = 0; r < NR; ++r) { float t = 0.f;
#pragma unroll
        for (int j = 0; j < 4; ++j) t += (v[r][j].x * v[r][j].x + v[r][j].y * v[r][j].y) + (v[r][j].z * v[r][j].z + v[r][j].w * v[r][j].w);
        s[r] = t; }
#pragma unroll
    for (int o2 = 1; o2 < 64; o2 <<= 1) {
#pragma unroll
        for (int r = 0; r < NR; ++r) s[r] += __shfl_xor(s[r], o2); }
    const f32x4* wr = (const f32x4*)w + lane;
    f32x4 g[4];
#pragma unroll
    for (int j = 0; j < 4; ++j) g[j] = wr[64 * j];
#pragma unroll
    for (int r = 0; r < NR; ++r) { const float rstd = 1.0f / sqrtf(s[r] * (1.f / DM) + EPS);
        unsigned long long* o8 = (unsigned long long*)(o + (size_t)(m0 + r * mstride) * DM) + lane;
#pragma unroll
        for (int j = 0; j < 4; ++j) o8[64 * j] = (unsigned long long)pk2(v[r][j].x * rstd * g[j].x, v[r][j].y * rstd * g[j].y) | ((unsigned long long)pk2(v[r][j].z * rstd * g[j].z, v[r][j].w * rstd * g[j].w) << 32); }
}
template <int NR> __device__ __forceinline__ void rms_rows_f32(float* x, const float* w, int m0, int mstride, int lane) {
    f32x4 v[NR][4]; float s[NR];
#pragma unroll
    for (int r = 0; r < NR; ++r) { const f32x4* xr = (const f32x4*)(x + (size_t)(m0 + r * mstride) * DM) + lane;
#pragma unroll
        for (int j = 0; j < 4; ++j) v[r][j] = xr[64 * j]; }
#pragma unroll
    for (int r = 0; r < NR; ++r) { float t = 0.f;
#pragma unroll
        for (int j = 0; j < 4; ++j) t += (v[r][j].x * v[r][j].x + v[r][j].y * v[r][j].y) + (v[r][j].z * v[r][j].z + v[r][j].w * v[r][j].w);
        s[r] = t; }
#pragma unroll
    for (int o2 = 1; o2 < 64; o2 <<= 1) {
#pragma unroll
        for (int r = 0; r < NR; ++r) s[r] += __shfl_xor(s[r], o2); }
    const f32x4* wr = (const f32x4*)w + lane;
    f32x4 g[4];
#pragma unroll
    for (int j = 0; j < 4; ++j) g[j] = wr[64 * j];
#pragma unroll
    for (int r = 0; r < NR; ++r) { const float rstd = 1.0f / sqrtf(s[r] * (1.f / DM) + EPS);
        f32x4* xo = (f32x4*)(x + (size_t)(m0 + r * mstride) * DM) + lane;
#pragma unroll
        for (int j = 0; j < 4; ++j) xo[64 * j] = (v[r][j] * rstd) * g[j]; }
}
template <int NR> __device__ __forceinline__ void prep_rows(const Params& P, int l, int m0, int mstride, int lane) {
    const bf16* proj = (const bf16*)(P.ws + WS_PROJ);
    unsigned wq[NR][3], wk[NR][2]; float sq[NR], sk[NR]; float x1[NR], x2[NR], cc[NR], ss[NR];
#pragma unroll
    for (int r = 0; r < NR; ++r) { const int row = m0 + r * mstride; const bf16* pr = proj + (size_t)row * NINP;
        const unsigned* s1 = (const unsigned*)(pr + COL_CQ); const unsigned* s2 = (const unsigned*)(pr + COL_CKV);
#pragma unroll
        for (int j = 0; j < 3; ++j) wq[r][j] = s1[lane + 64 * j];
#pragma unroll
        for (int j = 0; j < 2; ++j) wk[r][j] = s2[lane + 64 * j];
        x1[r] = bf1(pr[COL_KPE + (lane & 15)]); x2[r] = bf1(pr[COL_KPE + 16 + (lane & 15)]);
        cc[r] = ((const float*)(P.ws + WS_COS))[(size_t)row * 16 + (lane & 15)]; ss[r] = ((const float*)(P.ws + WS_SIN))[(size_t)row * 16 + (lane & 15)]; }
#pragma unroll
    for (int r = 0; r < NR; ++r) { float a = 0.f, c = 0.f;
#pragma unroll
        for (int j = 0; j < 3; ++j) { const float p = bflo(wq[r][j]), q = bfhi(wq[r][j]); a += p * p + q * q; }
#pragma unroll
        for (int j = 0; j < 2; ++j) { const float p = bflo(wk[r][j]), q = bfhi(wk[r][j]); c += p * p + q * q; }
        sq[r] = a; sk[r] = c; }
#pragma unroll
    for (int o2 = 1; o2 < 64; o2 <<= 1) {
#pragma unroll
        for (int r = 0; r < NR; ++r) { sq[r] += __shfl_xor(sq[r], o2); sk[r] += __shfl_xor(sk[r], o2); } }
    const float* gq = P.q_norm + l * 384; const float* gk = P.kv_norm + l * 256;
#pragma unroll
    for (int r = 0; r < NR; ++r) { const int row = m0 + r * mstride;
        const float rq = 1.0f / sqrtf(sq[r] * (1.f / 384.f) + EPS), rk = 1.0f / sqrtf(sk[r] * (1.f / 256.f) + EPS);
        unsigned* dq = (unsigned*)((bf16*)(P.ws + WS_CQN) + (size_t)row * 384); unsigned* dk = (unsigned*)((bf16*)(P.ws + WS_CKVN) + (size_t)row * 256);
#pragma unroll
        for (int j = 0; j < 3; ++j) { const int c = 2 * (lane + 64 * j); dq[lane + 64 * j] = pk2(bflo(wq[r][j]) * rq * gq[c], bfhi(wq[r][j]) * rq * gq[c + 1]); }
#pragma unroll
        for (int j = 0; j < 2; ++j) { const int c = 2 * (lane + 64 * j); dk[lane + 64 * j] = pk2(bflo(wk[r][j]) * rk * gk[c], bfhi(wk[r][j]) * rk * gk[c + 1]); }
        if (lane < 16) { bf16* kd = (bf16*)(P.ws + WS_KPE) + (size_t)row * 32;
            kd[lane] = (bf16)f2bf(x1[r] * cc[r] - x2[r] * ss[r]); kd[lane + 16] = (bf16)f2bf(x1[r] * ss[r] + x2[r] * cc[r]); } }
}
template <int NR> __device__ __forceinline__ void ssdnorm_rows(const Params& P, int l, int m0, int mstride, int lane) {
    v4u a[NR], b[NR]; float s[NR];
#pragma unroll
    for (int r = 0; r < NR; ++r) { const v4u* mr = (const v4u*)((const bf16*)(P.ws + WS_MIX) + (size_t)(m0 + r * mstride) * MIXW); a[r] = mr[lane]; b[r] = mr[lane + 64]; }
#pragma unroll
    for (int r = 0; r < NR; ++r) { const unsigned wa[4] = {a[r].x, a[r].y, a[r].z, a[r].w}, wb[4] = {b[r].x, b[r].y, b[r].z, b[r].w}; float t = 0.f;
#pragma unroll
        for (int j = 0; j < 4; ++j) { const float p = bflo(wa[j]), q = bfhi(wa[j]), u = bflo(wb[j]), v = bfhi(wb[j]); t += p * p + q * q + u * u + v * v; }
        s[r] = t; }
#pragma unroll
    for (int o2 = 1; o2 < 64; o2 <<= 1) {
#pragma unroll
        for (int r = 0; r < NR; ++r) s[r] += __shfl_xor(s[r], o2); }
    const float* g = P.ssd_norm + l * 1024;
    const f32x4 ga0 = *(const f32x4*)(g + 8 * lane), ga1 = *(const f32x4*)(g + 8 * lane + 4), gb0 = *(const f32x4*)(g + 512 + 8 * lane), gb1 = *(const f32x4*)(g + 512 + 8 * lane + 4);
#pragma unroll
    for (int r = 0; r < NR; ++r) { const float rstd = 1.0f / sqrtf(s[r] * (1.f / 1024.f) + EPS);
        v4u oa, ob;
        oa.x = pk2(bflo(a[r].x) * rstd * ga0[0], bfhi(a[r].x) * rstd * ga0[1]); oa.y = pk2(bflo(a[r].y) * rstd * ga0[2], bfhi(a[r].y) * rstd * ga0[3]);
        oa.z = pk2(bflo(a[r].z) * rstd * ga1[0], bfhi(a[r].z) * rstd * ga1[1]); oa.w = pk2(bflo(a[r].w) * rstd * ga1[2], bfhi(a[r].w) * rstd * ga1[3]);
        ob.x = pk2(bflo(b[r].x) * rstd * gb0[0], bfhi(b[r].x) * rstd * gb0[1]); ob.y = pk2(bflo(b[r].y) * rstd * gb0[2], bfhi(b[r].y) * rstd * gb0[3]);
        ob.z = pk2(bflo(b[r].z) * rstd * gb1[0], bfhi(b[r].z) * rstd * gb1[1]); ob.w = pk2(bflo(b[r].w) * rstd * gb1[2], bfhi(b[r].w) * rstd * gb1[3]);
        v4u* mo = (v4u*)((bf16*)(P.ws + WS_MIX) + (size_t)(m0 + r * mstride) * MIXW); mo[lane] = oa; mo[lane + 64] = ob; }
}
__device__ __forceinline__ void bc_prepass_generic(const Params& P, int l, int gtid, int ngt) {
    const bf16* proj = (const bf16*)(P.ws + WS_PROJ); bf16* bc = (bf16*)(P.ws + WS_BC);
    const float* cw = P.ssd_conv_w + (size_t)l * 4 * 1536 + 1024; const float* cbias = P.ssd_conv_b + (size_t)l * 1536 + 1024;
    const int c8 = (gtid & 63) * 8;
    f32x4 w0[4], w1[4];
#pragma unroll
    for (int k = 0; k < 4; ++k) { w0[k] = *(const f32x4*)(cw + k * 1536 + c8); w1[k] = *(const f32x4*)(cw + k * 1536 + c8 + 4); }
    const f32x4 b0 = *(const f32x4*)(cbias + c8), b1 = *(const f32x4*)(cbias + c8 + 4);
    for (int u = gtid; u < MROWS * 64; u += 4 * ngt) {
        v4u v[4][4]; int rows[4];
#pragma unroll
        for (int q = 0; q < 4; ++q) { const int row = (u + q * ngt) >> 6; rows[q] = row; const int sp = row & (SEQ - 1);
#pragma unroll
            for (int k = 0; k < 4; ++k) { const int rr = (sp - 3 + k >= 0) ? row - 3 + k : row; v[q][k] = *(const v4u*)(proj + (size_t)rr * NINP + COL_XBC + 1024 + c8); } }
#pragma unroll
        for (int q = 0; q < 4; ++q) { const int row = rows[q]; const int sp = row & (SEQ - 1);
            f32x4 a0 = b0, a1 = b1;
#pragma unroll
            for (int k = 0; k < 4; ++k) { const float m = (sp - 3 + k >= 0) ? 1.f : 0.f; const v4u t = v[q][k];
                a0 += (w0[k] * m) * (f32x4){bflo(t.x), bfhi(t.x), bflo(t.y), bfhi(t.y)}; a1 += (w1[k] * m) * (f32x4){bflo(t.z), bfhi(t.z), bflo(t.w), bfhi(t.w)}; }
            v4u o; o.x = pk2(pg8::fast_silu(a0[0]), pg8::fast_silu(a0[1])); o.y = pk2(pg8::fast_silu(a0[2]), pg8::fast_silu(a0[3]));
            o.z = pk2(pg8::fast_silu(a1[0]), pg8::fast_silu(a1[1])); o.w = pk2(pg8::fast_silu(a1[2]), pg8::fast_silu(a1[3]));
            if (row < MROWS) *(v4u*)(bc + (size_t)row * 512 + c8) = o; }
    }
}
__device__ __forceinline__ void bc_prepass(const Params& P, int l, int gtid, int ngt) {
    const int nseg = ngt >> 6; const int rps = (nseg > 0) ? MROWS / nseg : 0;
    if ((ngt & 63) != 0 || nseg * rps != MROWS || (rps & 3) != 0 || (SEQ % rps) != 0) { bc_prepass_generic(P, l, gtid, ngt); return; }
    const bf16* proj = (const bf16*)(P.ws + WS_PROJ); bf16* bc = (bf16*)(P.ws + WS_BC);
    const float* cw = P.ssd_conv_w + (size_t)l * 4 * 1536 + 1024; const float* cbias = P.ssd_conv_b + (size_t)l * 1536 + 1024;
    const int c8 = (gtid & 63) * 8; const int row0 = (gtid >> 6) * rps;
    f32x4 w0[4], w1[4];
#pragma unroll
    for (int k = 0; k < 4; ++k) { w0[k] = *(const f32x4*)(cw + k * 1536 + c8); w1[k] = *(const f32x4*)(cw + k * 1536 + c8 + 4); }
    const f32x4 b0 = *(const f32x4*)(cbias + c8), b1 = *(const f32x4*)(cbias + c8 + 4);
    const bf16* src = proj + (size_t)row0 * NINP + COL_XBC + 1024 + c8; bf16* dst = bc + (size_t)row0 * 512 + c8;
    const bool seqstart = (row0 & (SEQ - 1)) == 0;
    v4u h0 = (v4u){0u, 0u, 0u, 0u}, h1 = h0, h2 = h0;
    if (!seqstart) { h0 = *(const v4u*)(src - 3 * (long)NINP); h1 = *(const v4u*)(src - 2 * (long)NINP); h2 = *(const v4u*)(src - (long)NINP); }
#define BC_TAP(A0, A1, W0, W1, T) do { A0 += W0 * (f32x4){bflo(T.x), bfhi(T.x), bflo(T.y), bfhi(T.y)}; A1 += W1 * (f32x4){bflo(T.z), bfhi(T.z), bflo(T.w), bfhi(T.w)}; } while (0)
#define BC_OUT(R, X0, X1, X2, X3) do { f32x4 a0 = b0, a1 = b1; BC_TAP(a0, a1, w0[0], w1[0], X0); BC_TAP(a0, a1, w0[1], w1[1], X1); BC_TAP(a0, a1, w0[2], w1[2], X2); BC_TAP(a0, a1, w0[3], w1[3], X3); \
        v4u o; o.x = pk2(pg8::fast_silu(a0[0]), pg8::fast_silu(a0[1])); o.y = pk2(pg8::fast_silu(a0[2]), pg8::fast_silu(a0[3])); \
        o.z = pk2(pg8::fast_silu(a1[0]), pg8::fast_silu(a1[1])); o.w = pk2(pg8::fast_silu(a1[2]), pg8::fast_silu(a1[3])); *(v4u*)(dst + (size_t)(R) * 512) = o; } while (0)
    for (int r = 0; r < rps; r += 4) {
        const v4u c0 = *(const v4u*)(src + (size_t)(r + 0) * NINP), c1 = *(const v4u*)(src + (size_t)(r + 1) * NINP), c2 = *(const v4u*)(src + (size_t)(r + 2) * NINP), c3 = *(const v4u*)(src + (size_t)(r + 3) * NINP);
        BC_OUT(r + 0, h0, h1, h2, c0); BC_OUT(r + 1, h1, h2, c0, c1); BC_OUT(r + 2, h2, c0, c1, c2); BC_OUT(r + 3, c0, c1, c2, c3);
        h0 = c1; h1 = c2; h2 = c3;
    }
#undef BC_TAP
#undef BC_OUT
}
constexpr int BPI = 136;
constexpr int SL_X = 0, SL_X2 = 128  , SL_B = 34816, SL_C = 69632, SL_H = 104448, SL_DT = 121856, SL_CUM = SL_DT + 512, SL_W = SL_CUM + 512, SL_EC = SL_W + 512, SL_F = SL_EC + 512, SL_CR = SL_F + 512, SL_CW = SL_CR + 16  ;
__device__ __forceinline__ bf16x8 tr_frag(const unsigned char* base, int pitch_bytes) {
    const s16x4 lo = __builtin_bit_cast(s16x4, __builtin_amdgcn_ds_read_tr16_b64_v4i16((LAS s16x4*)(const LAS unsigned char*)base));
    const s16x4 hi4 = __builtin_bit_cast(s16x4, __builtin_amdgcn_ds_read_tr16_b64_v4i16((LAS s16x4*)((const LAS unsigned char*)base + 8 * pitch_bytes)));
    return (bf16x8){lo[0], lo[1], lo[2], lo[3], hi4[0], hi4[1], hi4[2], hi4[3]};
}
__device__ __forceinline__ void ssd_item(const Params& P, int l, int b, int h, unsigned char* lds, int tid) {
    const int lane = tid & 63, wid = tid >> 6, r32 = lane & 31, hi = lane >> 5;
    const int pb = wid & 1, lj = ((wid >> 1) & 1) ? ((wid >> 2) ? 2 : 1) : ((wid >> 2) ? 3 : 0), pb2 = wid >> 2, nb = wid & 3;
    const int trg = lane >> 4, tri = lane & 15;
    const int tr_row = 4 * (trg >> 1) + (tri >> 2), tr_col = 16 * (trg & 1) + 4 * (tri & 3);
    const int g = h >> 3;
    const float LOG2E = 1.4426950408889634f;
    const float aneg2 = -__expf(P.ssd_a_log[l * 16 + h]) * LOG2E; const float dtb = P.ssd_dt_bias[l * 16 + h]; const float dsk = P.ssd_d[l * 16 + h];
    const bf16* proj = (const bf16*)(P.ws + WS_PROJ); bf16* mix = (bf16*)(P.ws + WS_MIX);
    float* dtA = (float*)(lds + SL_DT); float* cumA = (float*)(lds + SL_CUM); float* wA = (float*)(lds + SL_W); float* ecA = (float*)(lds + SL_EC); float* fA = (float*)(lds + SL_F); float* crA = (float*)(lds + SL_CR);
    const int cp = tid & 31, seg = tid >> 5, ch = cp * 2, t0 = 8 * seg;
    const int cc = h * 64 + ch;
    __syncthreads();
    if (tid < 32) { const float* cw = P.ssd_conv_w + (size_t)l * 4 * 1536; const float* cbias = P.ssd_conv_b + (size_t)l * 1536; float* d = (float*)(lds + SL_CW) + tid * 12;
#pragma unroll
      for (int k = 0; k < 4; ++k) { d[k] = cw[k * 1536 + cc]; d[4 + k] = cw[k * 1536 + cc + 1]; }
      d[8] = cbias[cc]; d[9] = cbias[cc + 1]; d[10] = 0.f; d[11] = 0.f; }
    const float* cwl = (const float*)(lds + SL_CW) + cp * 12;
    unsigned char* dimg = lds + SL_X + ch * 2 + t0 * BPI * 2;
    const float* wAt = wA + t0;
    constexpr int dpitch = BPI * 2;
    unsigned raw[11];
    v4u bcr[8];
    unsigned dtr0 = 0, dtr1 = 0;
    const bf16* pcol = proj + (size_t)b * SEQ * NINP + COL_XBC + cc;
    const bf16* bcp = (const bf16*)(P.ws + WS_BC) + ((size_t)b * SEQ + (tid >> 5)) * 512 + g * 128 + ((tid & 31) < 16 ? (tid & 31) * 8 : 256 + ((tid & 31) - 16) * 8);
    unsigned char* bcdst = lds + ((tid & 31) < 16 ? SL_B + (tid & 31) * 16 : SL_C + ((tid & 31) - 16) * 16) + (tid >> 5) * BPI * 2;
#define SSD_LOADRAW(c_) do { \
        { const bf16* pp_ = pcol + ((long)(c_) * 128 + t0 - 3) * NINP; \
        _Pragma("unroll") for (int i = 0; i < 11; ++i) { raw[i] = *(const unsigned*)pp_; pp_ += NINP; } \
        if ((c_) == 0 && seg == 0) { raw[0] = 0u; raw[1] = 0u; raw[2] = 0u; } \
        _Pragma("unroll") for (int j = 0; j < 8; ++j) bcr[j] = *(const v4u*)(bcp + ((size_t)(c_) * 128 + 16 * j) * 512); } } while (0)
#define SSD_LOADDT(c_) do { \
        if (wid == 0) { const bf16* dp = proj + ((size_t)b * SEQ + (size_t)(c_) * 128 + 2 * lane) * NINP + COL_DT + h; dtr0 = dp[0]; dtr1 = dp[NINP]; } } while (0)
    SSD_LOADDT(0);
    SSD_LOADRAW(0);
    f32x16 Hacc;
#pragma unroll
    for (int r = 0; r < 16; ++r) Hacc[r] = 0.f;
    __syncthreads();
    for (int i = tid; i < 64 * BPI / 2; i += NTHR) ((unsigned*)(lds + SL_H))[i] = 0u;
    for (int c = 0; c < SEQ / 128; ++c) {
        const size_t row0 = (size_t)b * SEQ + (size_t)c * 128;
        if (wid == 0) {
            const float v0 = bf1((bf16)dtr0) + dtb, v1 = bf1((bf16)dtr1) + dtb;
            const float dt0 = v0 > 20.f ? v0 : log1pf(__expf(v0)), dt1 = v1 > 20.f ? v1 : log1pf(__expf(v1));
            const float da0 = dt0 * aneg2, da1 = dt1 * aneg2;
            const float s1 = da0 + da1; float x = s1;
#pragma unroll
            for (int o = 1; o < 64; o <<= 1) { const float t = __shfl_up(x, o); if (lane >= o) x += t; }
            const float c0 = x - s1 + da0, c1 = x; const float tot = __shfl(x, 63);
            dtA[2 * lane] = dt0; dtA[2 * lane + 1] = dt1; cumA[2 * lane] = c0; cumA[2 * lane + 1] = c1;
            wA[2 * lane] = dt0 * __builtin_amdgcn_exp2f(tot - c0); wA[2 * lane + 1] = dt1 * __builtin_amdgcn_exp2f(tot - c1);
            ecA[2 * lane] = __builtin_amdgcn_exp2f(c0); ecA[2 * lane + 1] = __builtin_amdgcn_exp2f(c1);
            { const float cend = __shfl(x, lane | 15);
              fA[2 * lane] = dt0 * __builtin_amdgcn_exp2f(cend - c0); fA[2 * lane + 1] = dt1 * __builtin_amdgcn_exp2f(cend - c1);
              if ((lane & 15) == 0) crA[lane >> 4] = cend; }
        }
        LBAR();
        {
            const f32x4 cwa = *(const f32x4*)cwl, cwb = *(const f32x4*)(cwl + 4), cwc = *(const f32x4*)(cwl + 8);
            typedef float f2 __attribute__((ext_vector_type(2)));
            const f2 wk[4] = {(f2){cwa[0], cwb[0]}, (f2){cwa[1], cwb[1]}, (f2){cwa[2], cwb[2]}, (f2){cwa[3], cwb[3]}}; const f2 bias2 = (f2){cwc[0], cwc[1]};
            f2 xr[11];
#pragma unroll
            for (int i = 0; i < 11; ++i) xr[i] = (f2){bflo(raw[i]), bfhi(raw[i])};
#pragma unroll
            for (int i = 0; i < 8; ++i) {
                f2 a = bias2;
#pragma unroll
                for (int k = 0; k < 4; ++k) a += wk[k] * xr[i + k];
                const f2 e = a * -1.4426950408889634f;
                f2 den; den.x = __builtin_amdgcn_exp2f(e.x); den.y = __builtin_amdgcn_exp2f(e.y); den += 1.0f;
                f2 rc; rc.x = __builtin_amdgcn_rcpf(den.x); rc.y = __builtin_amdgcn_rcpf(den.y);
                a = a * rc;
                *(unsigned*)(dimg + i * dpitch) = pk2(a.x, a.y);
                const f2 aw = a * wAt[i]; *(unsigned*)(dimg + SL_X2 + i * dpitch) = pk2(aw.x, aw.y);
            }
#pragma unroll
            for (int j = 0; j < 8; ++j) *(v4u*)(bcdst + 16 * j * BPI * 2) = bcr[j];
        }
        asm volatile("" ::: "memory");
        if (c + 1 < SEQ / 128) { SSD_LOADDT(c + 1); }
        const int lrow = 32 * lj + r32;
        v2u zr[4];
#pragma unroll
        for (int r4 = 0; r4 < 4; ++r4) zr[r4] = *(const v2u*)(proj + (row0 + lrow) * NINP + COL_Z + h * 64 + 32 * pb + 8 * r4 + 4 * hi);
        LBAR();
        const float cl = cumA[lrow];
        const unsigned char* cfp = lds + SL_C + (lrow * BPI + 8 * hi) * 2;
#define CF(ks) (*(const bf16x8*)(cfp + 32 * (ks)))
        f32x16 y;
        { f32x16 T;
#pragma unroll
          for (int r = 0; r < 16; ++r) T[r] = 0.f;
#pragma unroll
          for (int ks = 0; ks < 8; ++ks) { const bf16x8 hf = *(const bf16x8*)(lds + SL_H + ((32 * pb + r32) * BPI + 16 * ks + 8 * hi) * 2); T = __builtin_amdgcn_mfma_f32_32x32x16_bf16(hf, CF(ks), T, 0, 0, 0); }
          const float ecl = ecA[lrow];
#pragma unroll
          for (int r = 0; r < 16; ++r) y[r] = ecl * T[r]; }
#define SSD_SCORES(si_) \
            f32x16 s; \
            _Pragma("unroll") for (int r = 0; r < 16; ++r) s[r] = 0.f; \
            _Pragma("unroll") for (int ks = 0; ks < 8; ++ks) { const bf16x8 bfr = *(const bf16x8*)(lds + SL_B + ((32 * (si_) + r32) * BPI + 16 * ks + 8 * hi) * 2); s = __builtin_amdgcn_mfma_f32_32x32x16_bf16(bfr, CF(ks), s, 0, 0, 0); }
#define SSD_APPLY(si_) do { \
            const v4u pf0 = (v4u){pk2(s[0], s[1]), pk2(s[2], s[3]), pk2(s[4], s[5]), pk2(s[6], s[7])}; \
            const v4u pf1 = (v4u){pk2(s[8], s[9]), pk2(s[10], s[11]), pk2(s[12], s[13]), pk2(s[14], s[15])}; \
            { const bf16x8 xa = tr_frag(lds + SL_X + ((32 * (si_) + tr_row) * BPI + 32 * pb + tr_col) * 2, BPI * 2); \
              y = __builtin_amdgcn_mfma_f32_32x32x16_bf16(xa, __builtin_bit_cast(bf16x8, pf0), y, 0, 0, 0); } \
            { const bf16x8 xa = tr_frag(lds + SL_X + ((32 * (si_) + 16 + tr_row) * BPI + 32 * pb + tr_col) * 2, BPI * 2); \
              y = __builtin_amdgcn_mfma_f32_32x32x16_bf16(xa, __builtin_bit_cast(bf16x8, pf1), y, 0, 0, 0); } } while (0)
        for (int si = 0; si < lj; ++si) {
            SSD_SCORES(si)
            const float el = __builtin_amdgcn_exp2f(cl - crA[si]);
#pragma unroll
            for (int r4 = 0; r4 < 4; ++r4) { const f32x4 f4 = *(const f32x4*)(fA + 32 * si + 8 * r4 + 4 * hi);
#pragma unroll
                for (int j = 0; j < 4; ++j) { const int r = 4 * r4 + j; s[r] = s[r] * (f4[j] * el); } }
            SSD_APPLY(si);
            asm volatile("" ::: "memory");
        }
        {
            SSD_SCORES(lj)
#pragma unroll
            for (int r = 0; r < 16; ++r) { const int cr = (r & 3) + 8 * (r >> 2) + 4 * hi; const int srow = 32 * lj + cr;
                const bool ok = (cr <= r32);
                const float arg = ok ? (cl - cumA[srow]) : 0.f;
                float gv = s[r] * __builtin_amdgcn_exp2f(arg) * dtA[srow];
                gv = ok ? gv : 0.f;
                if (cr == r32) gv += dsk;
                s[r] = gv; }
            SSD_APPLY(lj);
        }
#undef SSD_SCORES
#undef SSD_APPLY
        { const float dec = ecA[127];
#pragma unroll
          for (int r = 0; r < 16; ++r) Hacc[r] *= dec;
#pragma unroll
          for (int ks = 0; ks < 8; ++ks) {
              const bf16x8 xa = tr_frag(lds + SL_X2 + ((16 * ks + tr_row) * BPI + 32 * pb2 + tr_col) * 2, BPI * 2);
              const bf16x8 bb = tr_frag(lds + SL_B + ((16 * ks + tr_row) * BPI + 32 * nb + tr_col) * 2, BPI * 2);
              Hacc = __builtin_amdgcn_mfma_f32_32x32x16_bf16(xa, bb, Hacc, 0, 0, 0); } }
        LBAR();
        if (c + 1 < SEQ / 128) SSD_LOADRAW(c + 1);
#pragma unroll
        for (int r = 0; r < 16; ++r) { const int cr = (r & 3) + 8 * (r >> 2) + 4 * hi; *(bf16*)(lds + SL_H + ((32 * pb2 + cr) * BPI + 32 * nb + r32) * 2) = (bf16)f2bf(Hacc[r]); }
#pragma unroll
        for (int r4 = 0; r4 < 4; ++r4) {
            const int p0 = 32 * pb + 8 * r4 + 4 * hi;
            const v2u z = zr[r4];
            typedef float f2 __attribute__((ext_vector_type(2)));
            const f2 za = (f2){bflo(z.x), bfhi(z.x)}, zb = (f2){bflo(z.y), bfhi(z.y)};
            const f2 ea = za * -1.4426950408889634f, eb = zb * -1.4426950408889634f;
            f2 da, db; da.x = __builtin_amdgcn_exp2f(ea.x); da.y = __builtin_amdgcn_exp2f(ea.y); db.x = __builtin_amdgcn_exp2f(eb.x); db.y = __builtin_amdgcn_exp2f(eb.y); da += 1.0f; db += 1.0f;
            f2 ra, rb; ra.x = __builtin_amdgcn_rcpf(da.x); ra.y = __builtin_amdgcn_rcpf(da.y); rb.x = __builtin_amdgcn_rcpf(db.x); rb.y = __builtin_amdgcn_rcpf(db.y);
            const f2 oa = (f2){y[4 * r4 + 0], y[4 * r4 + 1]} * (za * ra), ob = (f2){y[4 * r4 + 2], y[4 * r4 + 3]} * (zb * rb);
            v2u o; o.x = pk2(oa.x, oa.y); o.y = pk2(ob.x, ob.y);
            *(v2u*)(mix + (row0 + lrow) * MIXW + h * 64 + p0) = o;
        }
    }
#undef SSD_LOADRAW
#undef SSD_LOADDT
    __syncthreads();
}
constexpr int PLP = 136;
template <int GI> __device__ __forceinline__ void pool_item_t(const Params& P, int l, int tile, unsigned char* lds, int tid) {
    constexpr int gi = GI, WSZ = 2 << GI;
    const int lane = tid & 63, wid = tid >> 6, r32 = lane & 31, hi = lane >> 5;
    const bf16* proj = (const bf16*)(P.ws + WS_PROJ); bf16* mix = (bf16*)(P.ws + WS_MIX);
    const bf16* wt = (const bf16*)(P.ws + WS_W + (size_t)l * W_LAYER + WO_POOL) + (size_t)gi * 128 * 128;
    unsigned char* WTi = lds; unsigned char* PLi = lds + 128 * PLP * 2;
    const int cp = lane, tbase = wid * 16;
    const int tq = wid >> 1, dh = wid & 1;
    unsigned rw[WSZ + 15];
#define POOL_LOADW(sub_) do { const int r0_ = tile * 256 + (sub_) * 128; const int s0_ = r0_ & (SEQ - 1); \
        const bf16* up_ = proj + (size_t)r0_ * NINP + COL_U + gi * 128 + cp * 2; \
        _Pragma("unroll") for (int i = 0; i < WSZ + 15; ++i) { const int t = tbase - (WSZ - 1) + i; const unsigned v = *(const unsigned*)(up_ + (long)((s0_ + t >= 0) ? t : 0) * NINP); rw[i] = (s0_ + t >= 0) ? v : 0u; } } while (0)
    POOL_LOADW(0);
    f32x4 scv[2][4];
#pragma unroll
    for (int dbi = 0; dbi < 2; ++dbi)
#pragma unroll
        for (int r4 = 0; r4 < 4; ++r4) scv[dbi][r4] = *(const f32x4*)(P.pool_scale + l * 512 + gi * 128 + 32 * (2 * dh + dbi) + 8 * r4 + 4 * hi);
    LBAR();
    for (int i = tid; i < 2048; i += NTHR) { const int d = i >> 4, chk = i & 15; *(v4u*)(WTi + (d * PLP + chk * 8) * 2) = *(const v4u*)(wt + d * 128 + chk * 8); }
    for (int sub = 0; sub < 2; ++sub) {
        const int r0 = tile * 256 + sub * 128; const int s0 = r0 & (SEQ - 1);
        LBAR();
        { float sa = 0.f, sb = 0.f;
#pragma unroll
          for (int i = 0; i < WSZ - 1; ++i) { sa += bflo(rw[i]); sb += bfhi(rw[i]); }
#pragma unroll
          for (int j = 0; j < 16; ++j) { const int t = tbase + j; const float a = bflo(rw[WSZ - 1 + j]), bq = bfhi(rw[WSZ - 1 + j]);
              sa += a; sb += bq; const int sp = s0 + t; const float inv = __builtin_amdgcn_rcpf((float)((sp + 1) < WSZ ? (sp + 1) : WSZ));
              *(unsigned*)(PLi + (t * PLP + cp * 2) * 2) = pk2(sa * inv - a, sb * inv - bq);
              sa -= bflo(rw[j]); sb -= bfhi(rw[j]); } }
        if (sub == 0) POOL_LOADW(1);
        LBAR();
        bf16x8 pfr[8];
#pragma unroll
        for (int ks = 0; ks < 8; ++ks) pfr[ks] = *(const bf16x8*)(PLi + ((32 * tq + r32) * PLP + 16 * ks + 8 * hi) * 2);
#pragma unroll
        for (int dbi = 0; dbi < 2; ++dbi) { const int db = 2 * dh + dbi;
            f32x16 acc;
#pragma unroll
            for (int r = 0; r < 16; ++r) acc[r] = 0.f;
#pragma unroll
            for (int ks = 0; ks < 8; ++ks) { const bf16x8 wf = *(const bf16x8*)(WTi + ((32 * db + r32) * PLP + 16 * ks + 8 * hi) * 2); acc = __builtin_amdgcn_mfma_f32_32x32x16_bf16(wf, pfr[ks], acc, 0, 0, 0); }
#pragma unroll
            for (int r4 = 0; r4 < 4; ++r4) { const int d0 = 32 * db + 8 * r4 + 4 * hi; const f32x4 sc = scv[dbi][r4];
                v2u o; o.x = pk2(acc[4 * r4 + 0] * sc[0], acc[4 * r4 + 1] * sc[1]); o.y = pk2(acc[4 * r4 + 2] * sc[2], acc[4 * r4 + 3] * sc[3]);
                *(v2u*)(mix + (size_t)(r0 + 32 * tq + r32) * MIXW + 1024 + gi * 128 + d0) = o; } }
    }
#undef POOL_LOADW
}
__device__ __forceinline__ void pool_item(const Params& P, int l, int tile, int gi, unsigned char* lds, int tid) {
    if (gi == 0) pool_item_t<0>(P, l, tile, lds, tid); else if (gi == 1) pool_item_t<1>(P, l, tile, lds, tid); else if (gi == 2) pool_item_t<2>(P, l, tile, lds, tid); else pool_item_t<3>(P, l, tile, lds, tid);
}
constexpr int KP = 104, VP = 72;
constexpr int ATT_BUF = 64 * KP * 2 + 64 * VP * 2;
__device__ __forceinline__ void attn_unit(const Params& P, int b, int h, int qb, unsigned char* lds, int tid) {
    const int lane = tid & 63, wid = tid >> 6, r32 = lane & 31, hi = lane >> 5;
    const bf16* QB = (const bf16*)(P.ws + WS_QB); const bf16* KVB = (const bf16*)(P.ws + WS_KVB); const bf16* KPE = (const bf16*)(P.ws + WS_KPE); bf16* mix = (bf16*)(P.ws + WS_MIX);
    const size_t rowb = (size_t)b * SEQ; const int q0 = qb * 256;
    const int rs = (wid < 4) ? wid : 11 - wid;
    bf16x8 qr[6];
    { const bf16* qp = QB + (rowb + q0 + rs * 32 + r32) * 768 + h * 96 + hi * 8;
#pragma unroll
      for (int d0 = 0; d0 < 6; ++d0) qr[d0] = *(const bf16x8*)(qp + d0 * 16); }
    f32x16 o0, o1;
#pragma unroll
    for (int r = 0; r < 16; ++r) { o0[r] = 0.f; o1[r] = 0.f; }
    float mrun = -1e30f, lrun = 0.f;
    const int NT = (q0 + 256) / 64;
    const int krow = tid >> 3, kch = tid & 7;
    const int prow = (tid & 255) >> 2, pch = tid & 3;
    v4u kreg, preg = (v4u){0u, 0u, 0u, 0u}, vreg;
    auto gload = [&](int t) {
        const size_t r = rowb + (size_t)t * 64;
        kreg = *(const v4u*)(KVB + (r + krow) * 1024 + h * 128 + kch * 8);
        vreg = *(const v4u*)(KVB + (r + krow) * 1024 + h * 128 + 64 + kch * 8);
        if (tid < 256) preg = *(const v4u*)(KPE + (r + prow) * 32 + pch * 8);
    };
    auto lstore = [&](int buf) {
        unsigned char* kb = lds + buf * ATT_BUF; unsigned char* vb = kb + 64 * KP * 2;
        *(v4u*)(kb + (krow * KP + kch * 8) * 2) = kreg;
        *(v4u*)(vb + (krow * VP + kch * 8) * 2) = vreg;
        if (tid < 256) *(v4u*)(kb + (prow * KP + 64 + pch * 8) * 2) = preg;
    };
    LBAR();
    gload(0); lstore(0);
    LBAR();
    const int qrel = rs * 32 + r32;
    const int trg = lane >> 4, tri = lane & 15;
    const int tr_row = 4 * (trg >> 1) + (tri >> 2), tr_col = 16 * (trg & 1) + 4 * (tri & 3);
    for (int t = 0; t < NT; ++t) {
        const int buf = t & 1;
        if (t + 1 < NT) gload(t + 1);
        const unsigned char* kb = lds + buf * ATT_BUF; const unsigned char* vb = kb + 64 * KP * 2;
        if (!(t - (NT - 4) >= 0 && 64 * (t - (NT - 4)) > 32 * __builtin_amdgcn_readfirstlane(rs) + 31)) {
        f32x16 p0, p1;
#pragma unroll
        for (int r = 0; r < 16; ++r) { p0[r] = 0.f; p1[r] = 0.f; }
#pragma unroll
        for (int d0 = 0; d0 < 6; ++d0) {
            const bf16x8 k0 = *(const bf16x8*)(kb + (r32 * KP + d0 * 16 + hi * 8) * 2);
            const bf16x8 k1 = *(const bf16x8*)(kb + ((32 + r32) * KP + d0 * 16 + hi * 8) * 2);
            p0 = __builtin_amdgcn_mfma_f32_32x32x16_bf16(k0, qr[d0], p0, 0, 0, 0);
            p1 = __builtin_amdgcn_mfma_f32_32x32x16_bf16(k1, qr[d0], p1, 0, 0, 0);
        }
        const int jb = t - (NT - 4);
        if (jb >= 0) {
#pragma unroll
            for (int r = 0; r < 16; ++r) { const int kv = 64 * jb + (r & 3) + 8 * (r >> 2) + 4 * hi; if (kv > qrel) p0[r] = -1e30f; if (kv + 32 > qrel) p1[r] = -1e30f; }
        }
        float mx = p0[0];
#pragma unroll
        for (int r = 1; r < 16; ++r) mx = fmaxf(mx, p0[r]);
#pragma unroll
        for (int r = 0; r < 16; ++r) mx = fmaxf(mx, p1[r]);
        mx = fmaxf(mx, __shfl_xor(mx, 32));
        const float mnew = fmaxf(mrun, mx);
        const float alpha = __builtin_amdgcn_exp2f(mrun - mnew);
        mrun = mnew;
        float ls = 0.f;
#pragma unroll
        for (int r = 0; r < 16; ++r) { p0[r] = __builtin_amdgcn_exp2f(p0[r] - mnew); p1[r] = __builtin_amdgcn_exp2f(p1[r] - mnew); ls += p0[r] + p1[r]; }
        lrun = lrun * alpha + ls;
#pragma unroll
        for (int r = 0; r < 16; ++r) { o0[r] *= alpha; o1[r] *= alpha; }
        v4u pf[2][2];
#pragma unroll
        for (int s = 0; s < 2; ++s) {
            pf[0][s] = (v4u){pk2(p0[8 * s + 0], p0[8 * s + 1]), pk2(p0[8 * s + 2], p0[8 * s + 3]), pk2(p0[8 * s + 4], p0[8 * s + 5]), pk2(p0[8 * s + 6], p0[8 * s + 7])};
            pf[1][s] = (v4u){pk2(p1[8 * s + 0], p1[8 * s + 1]), pk2(p1[8 * s + 2], p1[8 * s + 3]), pk2(p1[8 * s + 4], p1[8 * s + 5]), pk2(p1[8 * s + 6], p1[8 * s + 7])};
        }
#pragma unroll
        for (int blk = 0; blk < 2; ++blk)
#pragma unroll
            for (int s = 0; s < 2; ++s) {
                const bf16x8 pfrag = __builtin_bit_cast(bf16x8, pf[blk][s]);
#pragma unroll
                for (int db = 0; db < 2; ++db) {
                    const LAS unsigned char* vp = (const LAS unsigned char*)vb + ((32 * blk + 16 * s + tr_row) * VP + 32 * db + tr_col) * 2;
                    const s16x4 lo = __builtin_bit_cast(s16x4, __builtin_amdgcn_ds_read_tr16_b64_v4i16((LAS s16x4*)vp));
                    const s16x4 hi4 = __builtin_bit_cast(s16x4, __builtin_amdgcn_ds_read_tr16_b64_v4i16((LAS s16x4*)(vp + 8 * VP * 2)));
                    const bf16x8 vf = (bf16x8){lo[0], lo[1], lo[2], lo[3], hi4[0], hi4[1], hi4[2], hi4[3]};
                    if (db == 0) o0 = __builtin_amdgcn_mfma_f32_32x32x16_bf16(vf, pfrag, o0, 0, 0, 0);
                    else o1 = __builtin_amdgcn_mfma_f32_32x32x16_bf16(vf, pfrag, o1, 0, 0, 0);
                }
            }
        }
        if (t + 1 < NT) lstore(buf ^ 1);
        LBAR();
    }
    lrun += __shfl_xor(lrun, 32);
    const float rl = 1.0f / lrun;
    bf16* op = mix + (rowb + q0 + rs * 32 + r32) * MIXW + 1536 + h * 64;
#pragma unroll
    for (int r4 = 0; r4 < 4; ++r4) {
        const int d = 8 * r4 + 4 * hi;
        v2u w0, w1;
        w0.x = pk2(o0[4 * r4 + 0] * rl, o0[4 * r4 + 1] * rl); w0.y = pk2(o0[4 * r4 + 2] * rl, o0[4 * r4 + 3] * rl);
        w1.x = pk2(o1[4 * r4 + 0] * rl, o1[4 * r4 + 1] * rl); w1.y = pk2(o1[4 * r4 + 2] * rl, o1[4 * r4 + 3] * rl);
        *(v2u*)(op + d) = w0; *(v2u*)(op + 32 + d) = w1;
    }
}
__device__ __forceinline__ void ffn_fixup(const Params& P, int l, int gtid, int ngt) {
    const float* RAW = (const float*)(P.ws + WS_RAW); bf16* ACT = (bf16*)(P.ws + WS_ACT);
    const float* cw = P.ffn_conv_w + (size_t)l * 3 * 5632; const float* cb = P.ffn_conv_b + (size_t)l * 5632;
    const int total = (MROWS / 64) * 2 * DFF;
    for (int idx = gtid; idx < total; idx += ngt) {
        const int gc = idx % DFF; const int ri = idx / DFF; const int i = ri & 1, blk = ri >> 1;
        const int pn = gc >> 7, rc = gc & 127; const int cg_ = pn * 256 + rc, cv_ = cg_ + 128;
        const bool first = (blk & 63) == 0;
        const float* r_cur = RAW + ((size_t)blk * 4 + i) * 5632;
        const float* r_m1 = (i == 1) ? RAW + ((size_t)blk * 4 + 0) * 5632 : RAW + ((size_t)(blk - 1) * 4 + 3) * 5632;
        const float* r_m2 = (i == 1) ? RAW + ((size_t)(blk - 1) * 4 + 3) * 5632 : RAW + ((size_t)(blk - 1) * 4 + 2) * 5632;
        const bool z1 = first && (i == 0), z2 = first;
        const float g0 = r_cur[cg_], v0 = r_cur[cv_];
        const float g1 = z1 ? 0.f : r_m1[cg_], v1 = z1 ? 0.f : r_m1[cv_];
        const float g2 = z2 ? 0.f : r_m2[cg_], v2 = z2 ? 0.f : r_m2[cv_];
        const float gg = cb[gc] + cw[gc] * g2 + cw[5632 + gc] * g1 + cw[2 * 5632 + gc] * g0;
        const float vv = cb[DFF + gc] + cw[DFF + gc] * v2 + cw[5632 + DFF + gc] * v1 + cw[2 * 5632 + DFF + gc] * v0;
        ACT[(size_t)(blk * 64 + i) * DFF + gc] = (bf16)f2bf(silu_f(gg) * vv);
    }
}

#define XB_TMO      128
#define XB_XCNT(j)  (256  + 64 * (j))
#define XB_XSUB(j)  (1280 + 64 * (j))
#define XB_XGEN(j)  (2304 + 64 * (j))
#define XB_TOP      3328
#define XB_TOPGEN   3392
#define XCD_BAR_WORDS 3456
#define XB_SPIN_CAP (1u << 18)

__device__ __forceinline__ unsigned xb_ld(unsigned* p)              { return __hip_atomic_load(p, __ATOMIC_RELAXED, __HIP_MEMORY_SCOPE_AGENT); }
__device__ __forceinline__ unsigned xb_add(unsigned* p, unsigned v) { return __hip_atomic_fetch_add(p, v, __ATOMIC_RELAXED, __HIP_MEMORY_SCOPE_AGENT); }
__device__ __forceinline__ unsigned xb_xcc_id() { return (unsigned)__builtin_amdgcn_s_getreg((3 << 11) | 20) & 0xFu; }
#define XB_SPIN(cond, bar) do { unsigned _sp = 0; while (cond) { __builtin_amdgcn_s_sleep(1); \
    if ((++_sp & 255u) == 0u) { if (xb_ld(&(bar)[XB_TMO])) break; if (_sp > XB_SPIN_CAP) { atomicAdd(&(bar)[XB_TMO], 1u); break; } } } } while (0)

struct XcdBarrier {
    unsigned* bar; unsigned x; bool t0;
    volatile LAS unsigned* st;
};

__device__ __forceinline__ XcdBarrier xcd_barrier_post(unsigned* bar, volatile LAS unsigned* st, bool t0) {
    XcdBarrier b; b.bar = bar; b.x = xb_xcc_id(); b.st = st; b.t0 = t0;
    if (t0) (void)xb_add(&bar[XB_XCNT(b.x)], 1u);
    return b;
}
__device__ __forceinline__ void xcd_barrier_complete(unsigned* bar, unsigned x, unsigned& nloc, unsigned& nx) {
    const unsigned G = gridDim.x * gridDim.y * gridDim.z;
    unsigned sum, cnt, mine, sp = 0u;
    for (;;) {
        sum = 0u; cnt = 0u; mine = 0u;
#pragma unroll
        for (unsigned j = 0; j < 16; ++j) { const unsigned c = xb_ld(&bar[XB_XCNT(j)]); sum += c; cnt += (c > 0u) ? 1u : 0u; mine = (j == x) ? c : mine; }
        if (sum == G) break;
        __builtin_amdgcn_s_sleep(1);
        if ((++sp & 255u) == 0u) { if (xb_ld(&bar[XB_TMO])) break; if (sp > XB_SPIN_CAP) { atomicAdd(&bar[XB_TMO], 1u); break; } }
    }
    nloc = mine > 0u ? mine : 1u; nx = cnt > 0u ? cnt : 1u;
}

__device__ __forceinline__ void xcd_barrier(const XcdBarrier& b) {
    asm volatile("s_waitcnt vmcnt(0)" ::: "memory");
    __syncthreads();
    if (b.t0) {
        unsigned* bar = b.bar;
        __builtin_amdgcn_s_waitcnt(0);
        unsigned nloc = b.st[0], nx = b.st[1];
        if (nloc == 0u) { xcd_barrier_complete(bar, b.x, nloc, nx); b.st[0] = nloc; b.st[1] = nx; }
        const unsigned old = xb_add(&bar[XB_XSUB(b.x)], 1u);
        const unsigned gen = old / nloc;
        if (old + 1u == (gen + 1u) * nloc) {
            __builtin_amdgcn_fence(__ATOMIC_RELEASE, "agent");
            asm volatile("s_waitcnt vmcnt(0)" ::: "memory");
            const unsigned og = xb_add(&bar[XB_TOP], 1u);
            const unsigned tg = og / nx;
            if (og + 1u == (tg + 1u) * nx) xb_add(&bar[XB_TOPGEN], 1u);
            else XB_SPIN(xb_ld(&bar[XB_TOPGEN]) == tg, bar);
            __builtin_amdgcn_fence(__ATOMIC_ACQUIRE, "agent");
            xb_add(&bar[XB_XGEN(b.x)], 1u);
            asm volatile("s_waitcnt vmcnt(0)" ::: "memory");
        } else {
            XB_SPIN(xb_ld(&bar[XB_XGEN(b.x)]) == gen, bar);
            __builtin_amdgcn_fence(__ATOMIC_ACQUIRE, "agent");
            asm volatile("s_waitcnt vmcnt(0)" ::: "memory");
        }
    }
    __syncthreads();
}

__device__ __forceinline__ unsigned fresh_lane_id() { unsigned z = 0u; asm volatile("" : "+v"(z)); return __builtin_amdgcn_mbcnt_hi(~0u, __builtin_amdgcn_mbcnt_lo(~0u, z)); }
__global__ void __launch_bounds__(NTHR, 2) fwd_kernel(Params P) {
    extern __shared__ __attribute__((aligned(16))) unsigned char lds[];
    cg::grid_group grid = cg::this_grid();
    const int G = gridDim.x, bid = blockIdx.x;
    const int vbid = ((G & 7) == 0) ? ((bid & 7) * (G >> 3) + (bid >> 3)) : bid;
    const int wave_s = __builtin_amdgcn_readfirstlane((int)(threadIdx.x >> 6));
#define MYTID() (wave_s * 64 + (int)fresh_lane_id())
    PG8_LAS unsigned char* lds3 = (PG8_LAS unsigned char*)lds;
    volatile LAS unsigned* xst = (volatile LAS unsigned*)((LAS unsigned char*)lds + MISC_OFF);
    { const int t0_ = MYTID(); if (t0_ < 2) xst[t0_] = 0u;
      unsigned* barw = (unsigned*)(P.ws + WS_CTL); if (blockIdx.x == 0) for (int i = t0_; i < XCD_BAR_WORDS; i += NTHR) barw[i] = 0u; }
#ifndef PHM
#define PHM 0xFFFF
#endif
#ifndef REP_POOL
#define REP_POOL 1
#endif
#ifndef REP_P2
#define REP_P2 1
#endif
#ifndef REP_P8
#define REP_P8 1
#endif
#ifndef REP_P4
#define REP_P4 1
#endif
#ifndef REP_SYNC
#define REP_SYNC 0
#endif
#ifndef REP_P0
#define REP_P0 1
#endif
#ifndef REP_P2B
#define REP_P2B 1
#endif
#ifndef REP_P7
#define REP_P7 1
#endif
#ifndef REP_SSD
#define REP_SSD 1
#endif
#ifndef REP_ATT
#define REP_ATT 1
#endif
#define PH(n) if ((PHM >> (n)) & 1)
#if defined(__HIP_DEVICE_COMPILE__)
#define LOADP() const __attribute__((address_space(4))) Params* pp_ = (const __attribute__((address_space(4))) Params*)__builtin_amdgcn_kernarg_segment_ptr(); asm volatile("" : "+s"(pp_)); const Params Q = *pp_; unsigned char* const ws = Q.ws; (void)ws;
#else
#define LOADP() const Params Q = P; unsigned char* const ws = Q.ws; (void)ws;
#endif
#define TIDS() int tid = MYTID(); asm volatile("" : "+v"(tid)); const int lane = tid & 63; const int wave = __builtin_amdgcn_readfirstlane(tid >> 6); \
    const int gw = bid * 8 + wave, ngw = G * 8, gtid = bid * NTHR + tid, ngt = G * NTHR; (void)lane; (void)gw; (void)ngw; (void)gtid; (void)ngt;

    for (int rep = 0; rep < REP_P0; ++rep) { LOADP(); TIDS();
      PH(0) phase_weights(Q, lds, gw, ngw, lane, wave);
      PH(1) phase_rope_table(Q, gtid, ngt);
      for (int m = gw; m < MROWS; m += 8 * ngw) rms_rows_bf16<8>(Q.x, Q.attn_norm, (bf16*)(ws + WS_H), m, ngw, lane); }
    grid.sync();
    (void)xcd_barrier_post((unsigned*)(P.ws + WS_CTL), xst, MYTID() == 0);
#define GSYNC() do { LOADP(); XcdBarrier xb_; xb_.bar = (unsigned*)(ws + WS_CTL); xb_.x = xb_xcc_id(); xb_.st = (volatile LAS unsigned*)((LAS unsigned char*)lds + MISC_OFF); xb_.t0 = (MYTID() == 0); xcd_barrier(xb_); } while (0)

    for (int l = 0; l < DEPTH; ++l) {
        for (int rep = 0; rep < REP_P2; ++rep) PH(2) { LOADP(); const unsigned char* wb = ws + WS_W + (size_t)l * W_LAYER; pg8::Gemm g{(const bf16*)(ws + WS_H), (const bf16*)(wb + WO_IN), MROWS, NINP, 1024}; pg8::StaticOrder S; S.init(MROWS, NINP, G, bid);
          pg8::EpiStoreBf16 E{(bf16*)(ws + WS_PROJ), NINP};
          pg8::gemm_phase<pg8::EpiStoreBf16, pg8::StaticOrder, true, true>(lds3, g, S, E, MYTID()); }
        GSYNC();
        for (int rep = 0; rep < REP_P2B; ++rep) { LOADP(); TIDS();
          bc_prepass(Q, l, gtid, ngt);
          for (int rep = 0; rep < REP_POOL; ++rep) PH(4) for (int it = bid; it < 256 * 4; it += G) pool_item(Q, l, it >> 2, it & 3, lds, tid);
          PH(5) for (int m = gw; m < MROWS; m += 8 * ngw) prep_rows<8>(Q, l, m, ngw, lane); }
        GSYNC();
        { LOADP(); TIDS();
          for (int rep = 0; rep < REP_SSD; ++rep) { PH(3) for (int it = vbid; it < NB * 16; it += G) ssd_item(Q, l, it >> 4, it & 15, lds, tid); } }
        GSYNC();
        for (int rep = 0; rep < REP_P4; ++rep) PH(6) { LOADP(); const unsigned char* wb = ws + WS_W + (size_t)l * W_LAYER; pg8::Gemm g{(const bf16*)(ws + WS_CQN), (const bf16*)(wb + WO_UQ), MROWS, 768, 384}; pg8::StaticOrder S; S.init(MROWS, 768, G, bid);
          pg8::EpiQRope E{(bf16*)(ws + WS_QB), 768, (const float*)(ws + WS_COS), (const float*)(ws + WS_SIN), 0.10206207261596575f * 1.4426950408889634f};
          pg8::gemm_phase<pg8::EpiQRope, pg8::StaticOrder, true, true>(lds3, g, S, E, MYTID()); }
        for (int rep = 0; rep < REP_P4; ++rep) PH(7) { LOADP(); const unsigned char* wb = ws + WS_W + (size_t)l * W_LAYER; pg8::Gemm g{(const bf16*)(ws + WS_CKVN), (const bf16*)(wb + WO_UKV), MROWS, 1024, 256}; pg8::StaticOrder S; S.init(MROWS, 1024, G, bid);
          pg8::EpiStoreBf16 E{(bf16*)(ws + WS_KVB), 1024};
          pg8::gemm_phase<pg8::EpiStoreBf16, pg8::StaticOrder, true, true>(lds3, g, S, E, MYTID()); }
        { LOADP(); TIDS();
          PH(8) for (int m = gw; m < MROWS; m += 8 * ngw) ssdnorm_rows<8>(Q, l, m, ngw, lane); }
        GSYNC();
        { LOADP(); TIDS();
          for (int rep = 0; rep < REP_ATT; ++rep) PH(9) for (int v = vbid; v < 256; v += G) {
            const int bh = v >> 1, par = v & 1;
            for (int i = 7; i >= 0; --i) { const int qb = 2 * i + ((i & 1) ^ par);
                attn_unit(Q, bh >> 3, bh & 7, qb, lds, tid); }
          } }
        GSYNC();
        PH(10) { LOADP(); const unsigned char* wb = ws + WS_W + (size_t)l * W_LAYER; pg8::Gemm g{(const bf16*)(ws + WS_MIX), (const bf16*)(wb + WO_OUT), MROWS, 1024, 2048}; pg8::StaticOrder S; S.init(MROWS, 1024, G, bid);
          pg8::EpiResF32 E{(l == 0) ? Q.x : Q.out, Q.out, 1024};
          pg8::gemm_phase<pg8::EpiResF32, pg8::StaticOrder, true, true>(lds3, g, S, E, MYTID()); }
        GSYNC();
        for (int rep = 0; rep < REP_SYNC; ++rep) GSYNC();
        for (int rep = 0; rep < REP_P7; ++rep) { LOADP(); TIDS();
          for (int m = gw; m < MROWS; m += 8 * ngw) rms_rows_bf16<8>(Q.out, Q.ffn_norm + l * DM, (bf16*)(ws + WS_H), m, ngw, lane); }
        GSYNC();
        for (int rep = 0; rep < REP_P8; ++rep) PH(11) { LOADP(); const unsigned char* wb = ws + WS_W + (size_t)l * W_LAYER; pg8::Gemm g{(const bf16*)(ws + WS_H), (const bf16*)(wb + WO_UP), MROWS, 5632, 1024}; pg8::StaticOrder S; S.init(MROWS, 5632, G, bid);
          pg8::EpiFfnConv E{(bf16*)(ws + WS_ACT), (float*)(ws + WS_RAW), Q.ffn_conv_w + (size_t)l * 3 * 5632, Q.ffn_conv_b + (size_t)l * 5632};
          pg8::gemm_phase<pg8::EpiFfnConv, pg8::StaticOrder, true, true>(lds3, g, S, E, MYTID()); }
        GSYNC();
        { LOADP(); TIDS();
          PH(12) ffn_fixup(Q, l, gtid, ngt); }
        GSYNC();
        PH(13) { LOADP(); const unsigned char* wb = ws + WS_W + (size_t)l * W_LAYER; pg8::Gemm g{(const bf16*)(ws + WS_ACT), (const bf16*)(wb + WO_DOWN), MROWS, 1024, 2816}; pg8::StaticOrder S; S.init(MROWS, 1024, G, bid, 1);
          pg8::EpiResF32 E{Q.out, Q.out, 1024};
          pg8::gemm_phase<pg8::EpiResF32, pg8::StaticOrder, true, true>(lds3, g, S, E, MYTID()); }
        GSYNC();
        { LOADP(); TIDS();
          if (l + 1 < DEPTH) {
            for (int m = gw; m < MROWS; m += 8 * ngw) rms_rows_bf16<8>(Q.out, Q.attn_norm + (l + 1) * DM, (bf16*)(ws + WS_H), m, ngw, lane);
          } else {
            for (int m = gw; m < MROWS; m += 8 * ngw) rms_rows_f32<8>(Q.out, Q.final_norm, m, ngw, lane);
          } }
        if (l + 1 < DEPTH) GSYNC();
    }
}

extern "C" void kernel_launch(void* const* d_in, const int* in_sizes, int n_in, void* d_out, int out_size, void* d_ws, size_t ws_size, hipStream_t stream) {
    static int grid = 0;
    if (grid == 0) {
        if (n_in != 23 || ws_size < WS_END) { fprintf(stderr, "kernel_launch: unexpected inputs (n_in %d, ws %zu)\n", n_in, ws_size); grid = -1; return; }
        int dev = 0, cus = 0, per_cu = 0;
        hipGetDevice(&dev); hipDeviceGetAttribute(&cus, hipDeviceAttributeMultiprocessorCount, dev);
        hipFuncSetAttribute((const void*)fwd_kernel, hipFuncAttributeMaxDynamicSharedMemorySize, LDS_BYTES);
        hipOccupancyMaxActiveBlocksPerMultiprocessor(&per_cu, (const void*)fwd_kernel, NTHR, LDS_BYTES);
        if (per_cu < 1) per_cu = 1;
        grid = cus * per_cu;
        (void)hipGetLastError();
    }
    if (grid < 0) return;
    Params p{};
    p.x = (const float*)d_in[0]; p.pos = (const int*)d_in[1]; p.attn_norm = (const float*)d_in[2]; p.w_in = (const float*)d_in[3];
    p.ssd_conv_w = (const float*)d_in[4]; p.ssd_conv_b = (const float*)d_in[5]; p.ssd_dt_bias = (const float*)d_in[6]; p.ssd_a_log = (const float*)d_in[7];
    p.ssd_d = (const float*)d_in[8]; p.ssd_norm = (const float*)d_in[9]; p.pool_w = (const float*)d_in[10]; p.pool_scale = (const float*)d_in[11];
    p.q_norm = (const float*)d_in[12]; p.w_uq = (const float*)d_in[13]; p.kv_norm = (const float*)d_in[14]; p.w_ukv = (const float*)d_in[15];
    p.w_out = (const float*)d_in[16]; p.ffn_norm = (const float*)d_in[17]; p.w_up = (const float*)d_in[18]; p.ffn_conv_w = (const float*)d_in[19];
    p.ffn_conv_b = (const float*)d_in[20]; p.w_down = (const float*)d_in[21]; p.final_norm = (const float*)d_in[22];
    p.out = (float*)d_out; p.ws = (unsigned char*)d_ws;
    void* args[] = {&p};
    hipError_t e = hipLaunchCooperativeKernel((const void*)fwd_kernel, dim3(grid), dim3(NTHR), args, LDS_BYTES, stream);
    if (e != hipSuccess) fprintf(stderr, "cooperative launch failed: %s (grid %d)\n", hipGetErrorString(e), grid);
}
```
